# Optimizing an MI355X kernel written in HIP

```python
import jax, jax.numpy as jnp
from jax import lax
import numpy as np

D_MODEL = 1024
BATCH = 2
SEQ = 16384
DEPTH = 2

N_A = DEPTH // 2
N_B = DEPTH - N_A
CHUNK = 64
LEFT_CHUNKS = 8
BAND = (LEFT_CHUNKS + 1) * CHUNK
PAD = LEFT_CHUNKS * CHUNK
D_RNN = D_MODEL
LRU_BLOCKS = 8
LRU_BW = D_RNN // LRU_BLOCKS
CONV_W = 4
LRU_C = 8.0
N_HEADS = 16
HEAD_DIM = D_MODEL // N_HEADS
MAX_REL = 2 * CHUNK
MIN_REL = -(CHUNK - 1)
NREL = MAX_REL - MIN_REL + 1
D_FF = 4 * D_MODEL
EPS = 1e-6

kernel_name = 'yoco_rglru_chunk_relbias_hybrid'


def rmsnorm(x, g):
    xf = x.astype(jnp.float32)
    y = xf * lax.rsqrt(jnp.mean(xf * xf, axis=-1, keepdims=True) + EPS)
    return (y * g.astype(jnp.float32)).astype(x.dtype)


def causal_depthwise_conv(x, w, b):
    s = x.shape[1]
    xp = jnp.pad(x, ((0, 0), (CONV_W - 1, 0), (0, 0)))
    out = b + xp[:, 0:s] * w[0]
    for k in range(1, CONV_W):
        out = out + xp[:, k:k + s] * w[k]
    return out


def rg_lru(x, w_gate, b_gate, lam):
    bsz, s, _ = x.shape
    xf = x.astype(jnp.float32)
    xb = xf.reshape(bsz, s, LRU_BLOCKS, LRU_BW)
    g = jnp.einsum('bsnd,nde->bsne', xb, w_gate.astype(jnp.float32)) + b_gate.astype(jnp.float32)
    r = jax.nn.sigmoid(g[..., :LRU_BW]).reshape(bsz, s, D_RNN)
    i = jax.nn.sigmoid(g[..., LRU_BW:]).reshape(bsz, s, D_RNN)
    log_a = -LRU_C * r * jax.nn.softplus(-lam.astype(jnp.float32))
    a = jnp.exp(log_a)
    b = jnp.sqrt(-jnp.expm1(2.0 * log_a)) * (i * xf)

    def combine(left, right):
        a1, b1 = left
        a2, b2 = right
        return a1 * a2, a2 * b1 + b2

    _, h = lax.associative_scan(combine, (a, b), axis=1)
    return h.astype(x.dtype)


def recurrent_block(x, w_in, conv_w, conv_b, w_gate, b_gate, lam, w_out):
    u = x @ w_in
    gate, rec = u[..., :D_RNN], u[..., D_RNN:]
    rec = causal_depthwise_conv(rec, conv_w, conv_b)
    h = rg_lru(rec, w_gate, b_gate, lam)
    return (jax.nn.gelu(gate) * h) @ w_out


def shared_kv(x, kv_norm, w_kv, k_norm):
    bsz, s, _ = x.shape
    h = rmsnorm(x, kv_norm)
    kv = (h @ w_kv).reshape(bsz, s, 2, N_HEADS, HEAD_DIM)
    k = rmsnorm(kv[:, :, 0], k_norm)
    v = kv[:, :, 1]
    k = jnp.pad(k.transpose(0, 2, 1, 3), ((0, 0), (0, 0), (PAD, 0), (0, 0)))
    v = jnp.pad(v.transpose(0, 2, 1, 3), ((0, 0), (0, 0), (PAD, 0), (0, 0)))
    return k, v


def chunk_band_attention(q, k_pad, v_pad, rel_bias):
    bsz, s = q.shape[:2]
    nc = s // CHUNK
    qc = q.reshape(bsz, nc, CHUNK, N_HEADS, HEAD_DIM).transpose(1, 0, 3, 2, 4)
    qi = jnp.arange(CHUNK)[:, None]
    kj = jnp.arange(BAND)[None, :]
    dist = qi + PAD - kj
    idx = jnp.clip(dist, MIN_REL, MAX_REL) - MIN_REL
    bias = rel_bias.astype(jnp.float32)[:, idx]
    scale = HEAD_DIM ** -0.5

    def one_chunk(args):
        c, qb = args
        kb = lax.dynamic_slice_in_dim(k_pad, c * CHUNK, BAND, axis=2)
        vb = lax.dynamic_slice_in_dim(v_pad, c * CHUNK, BAND, axis=2)
        sc = jnp.einsum('bhqd,bhkd->bhqk', qb, kb).astype(jnp.float32) * scale + bias
        valid = (c * CHUNK - PAD + jnp.arange(BAND)) >= 0
        sc = jnp.where(valid, sc, -jnp.inf)
        p = jax.nn.softmax(sc, axis=-1).astype(vb.dtype)
        return jnp.einsum('bhqk,bhkd->bhqd', p, vb)

    o = lax.map(one_chunk, (jnp.arange(nc), qc))
    return o.transpose(1, 0, 3, 2, 4).reshape(bsz, s, N_HEADS * HEAD_DIM)


def sqrelu_mlp(x, w_up, w_down):
    return jnp.square(jax.nn.relu(x @ w_up)) @ w_down


def setup_inputs(seed: int = 0) -> dict:
    key = jax.random.key(seed)
    ks = jax.random.split(key, 24)
    f32 = jnp.float32

    def nrm(k, shape, fan_in):
        return jax.random.normal(k, shape, f32) * (fan_in ** -0.5)

    def gain(k, shape):
        return 1.0 + 0.05 * jax.random.normal(k, shape, f32)

    x = jax.random.normal(ks[0], (BATCH, SEQ, D_MODEL), f32)
    a_norm = gain(ks[1], (N_A, D_MODEL))
    a_w_in = nrm(ks[2], (N_A, D_MODEL, 2 * D_RNN), D_MODEL)
    a_conv_w = nrm(ks[3], (N_A, CONV_W, D_RNN), CONV_W)
    a_conv_b = 0.01 * jax.random.normal(ks[4], (N_A, D_RNN), f32)
    a_w_gate = nrm(ks[5], (N_A, LRU_BLOCKS, LRU_BW, 2 * LRU_BW), LRU_BW)
    a_b_gate = 0.01 * jax.random.normal(ks[6], (N_A, LRU_BLOCKS, 2 * LRU_BW), f32)
    u = jax.random.uniform(ks[7], (N_A, D_RNN), f32, 0.9, 0.999)
    base = u ** (1.0 / LRU_C)
    a_lambda = jnp.log(base) - jnp.log1p(-base)
    a_w_out = nrm(ks[8], (N_A, D_RNN, D_MODEL), D_RNN)
    kv_norm = gain(ks[9], (D_MODEL,))
    w_kv = nrm(ks[10], (D_MODEL, 2 * N_HEADS * HEAD_DIM), D_MODEL)
    k_norm = gain(ks[11], (HEAD_DIM,))
    b_norm = gain(ks[12], (N_B, D_MODEL))
    b_w_q = nrm(ks[13], (N_B, D_MODEL, N_HEADS * HEAD_DIM), D_MODEL)
    b_q_norm = gain(ks[14], (N_B, HEAD_DIM))
    b_rel_bias = 0.1 * jax.random.normal(ks[15], (N_B, N_HEADS, NREL), f32)
    b_w_o = nrm(ks[16], (N_B, N_HEADS * HEAD_DIM, D_MODEL), N_HEADS * HEAD_DIM)
    mlp_norm = gain(ks[17], (DEPTH, D_MODEL))
    w_up = nrm(ks[18], (DEPTH, D_MODEL, D_FF), D_MODEL)
    w_down = nrm(ks[19], (DEPTH, D_FF, D_MODEL), D_FF)
    return {'x': x, 'a_norm': a_norm, 'a_w_in': a_w_in, 'a_conv_w': a_conv_w,
            'a_conv_b': a_conv_b, 'a_w_gate': a_w_gate, 'a_b_gate': a_b_gate,
            'a_lambda': a_lambda, 'a_w_out': a_w_out, 'kv_norm': kv_norm, 'w_kv': w_kv,
            'k_norm': k_norm, 'b_norm': b_norm, 'b_w_q': b_w_q, 'b_q_norm': b_q_norm,
            'b_rel_bias': b_rel_bias, 'b_w_o': b_w_o, 'mlp_norm': mlp_norm,
            'w_up': w_up, 'w_down': w_down}


def reference(x, a_norm, a_w_in, a_conv_w, a_conv_b, a_w_gate, a_b_gate, a_lambda,
              a_w_out, kv_norm, w_kv, k_norm, b_norm, b_w_q, b_q_norm, b_rel_bias,
              b_w_o, mlp_norm, w_up, w_down):
    bsz, s, _ = x.shape
    h = x
    k_pad = None
    v_pad = None
    for l in range(DEPTH):
        if l < N_A:
            h = h + recurrent_block(rmsnorm(h, a_norm[l]), a_w_in[l], a_conv_w[l], a_conv_b[l],
                                    a_w_gate[l], a_b_gate[l], a_lambda[l], a_w_out[l])
        else:
            if l == N_A:
                k_pad, v_pad = shared_kv(h, kv_norm, w_kv, k_norm)
            j = l - N_A
            q = (rmsnorm(h, b_norm[j]) @ b_w_q[j]).reshape(bsz, s, N_HEADS, HEAD_DIM)
            q = rmsnorm(q, b_q_norm[j])
            o = chunk_band_attention(q, k_pad, v_pad, b_rel_bias[j])
            h = h + o @ b_w_o[j]
        h = h + sqrelu_mlp(rmsnorm(h, mlp_norm[l]), w_up[l], w_down[l])
    return h
```

```cpp
#include <hip/hip_runtime.h>
#include <hip/hip_cooperative_groups.h>
#include <cstdio>
#include <cstdint>
namespace cg = cooperative_groups;

#ifndef PROBE_REP_PH
#define PROBE_REP_PH 0
#define PROBE_REP_N 0
#define PROBE_XSYNC 0
#define PROBE_VARIANT 0
#endif
#ifndef MK_MULTI
#define MK_MULTI 0
#endif

#define LAS __attribute__((address_space(3)))
typedef unsigned short bf16_t;
typedef short bf16x8 __attribute__((ext_vector_type(8)));
typedef float f32x4 __attribute__((ext_vector_type(4)));
typedef float f32x2 __attribute__((ext_vector_type(2)));
typedef float f32x16 __attribute__((ext_vector_type(16)));
typedef unsigned u32x4 __attribute__((ext_vector_type(4)));
typedef unsigned u32x2 __attribute__((ext_vector_type(2)));

constexpr int BATCH = 2, SEQ = 16384, MTOK = BATCH * SEQ, D = 1024, FF = 4096, NH = 16, HD = 64, NREL = 192;
constexpr float EPS = 1e-6f, LOG2E = 1.4426950408889634f;
constexpr float QSCALE = 0.125f * LOG2E;

__device__ __forceinline__ unsigned cvt_pk_bf16(float lo, float hi) { unsigned r; asm volatile("v_cvt_pk_bf16_f32 %0, %1, %2" : "=v"(r) : "v"(lo), "v"(hi)); return r; }
__device__ __forceinline__ float bf_lo(unsigned u) { return __uint_as_float(u << 16); }
__device__ __forceinline__ float bf_hi(unsigned u) { return __uint_as_float(u & 0xffff0000u); }
__device__ __forceinline__ float fast_exp2(float x) { return __builtin_amdgcn_exp2f(x); }
__device__ __forceinline__ float fast_rcp(float x) { return __builtin_amdgcn_rcpf(x); }
__device__ __forceinline__ float sigmoidf_(float x) { return fast_rcp(1.f + fast_exp2(-LOG2E * x)); }
__device__ __forceinline__ float gelu_tanh(float v) { const float u = v * (1.f + 0.044715f * v * v); return v * fast_rcp(1.f + fast_exp2(-LOG2E * 1.5957691216057308f * u)); }

namespace pg8 {
constexpr int BM = 256, BK = 64, HALF = 128, HTB = HALF * BK * 2, STAGE_BYTES = 8 * HTB, NXCD = 8, WGM = 8;
__host__ __device__ __forceinline__ int lds_byte(int r, int c) { const int st = (r >> 4) * 2 + (c >> 5), rr = r & 15, cc = c & 31, ob = rr * 64 + cc * 2; return st * 1024 + (ob ^ (((ob >> 9) & 1) << 5)); }
__host__ __device__ __forceinline__ void stage_rc(int b, int& R, int& C) { const int st = b / 1024, sb = b % 1024, swz = sb ^ (((sb >> 9) & 1) << 5); R = (st >> 1) * 16 + swz / 64; C = (st & 1) * 32 + (swz % 64) / 2; }
__host__ __device__ __forceinline__ int perm32(int rho) { const int n = rho >> 4, i = rho & 15; return 8 * (i >> 2) + 4 * n + (i & 3); }

__device__ __forceinline__ void glds16_s(const void* sbase, unsigned voff, unsigned lds_dst) {
    unsigned keep;
    asm volatile("s_mov_b32 %0, m0\n\ts_mov_b32 m0, %3\n\ts_nop 0\n\tglobal_load_lds_dwordx4 %1, %2\n\ts_mov_b32 m0, %0"
                 : "=&s"(keep) : "v"(voff), "s"(sbase), "s"(lds_dst) : "memory");
}
struct Unit { int pm, pn; };
struct Gemm { const bf16_t* A; const bf16_t* Bt; int M, N, K, lda, ldb; long a_pn_off; };

struct StaticOrder {
    int nM, nN, nwg, G, c, wgm;
    __device__ void init(int M, int N, int G_, int c_, int wgm_ = WGM) { nM = M / BM; nN = N / BM; nwg = nM * nN; G = G_; c = c_; wgm = wgm_; }
    __device__ bool next(int i, Unit& u) const {
        const long L = (long)i * G + c; if (L >= nwg) return false;
        int wgid = (int)L; { const int q = nwg / NXCD, r = nwg % NXCD, xcd = wgid % NXCD, off = wgid / NXCD; wgid = (xcd < r ? xcd * (q + 1) : r * (q + 1) + (xcd - r) * q) + off; }
        const int nig = wgm * nN, gid = wgid / nig, fm = gid * wgm, gsz = (nM - fm) < wgm ? (nM - fm) : wgm;
        u.pm = fm + ((wgid % nig) % gsz); u.pn = (wgid % nig) / gsz; return true;
    }
};

typedef f32x4 Acc[2][2][4][2];
typedef f32x4 AccH[2][4][2];

template <class Epi>
__device__ __forceinline__ void rs_prep(const Epi& E, const Unit& u, int parity, LAS float* rsbuf, int tid) {
    if constexpr (Epi::RS_MODE != 0) {
        if (tid < 256) {
            asm volatile("" : "+v"(tid));
            const int row = (Epi::RS_MODE == 1 ? u.pm : u.pn) * 256 + tid;
            const f32x4* p = (const f32x4*)(E.ssq + (size_t)row * 16);
            const f32x4 a = p[0], b = p[1], c = p[2], d = p[3];
            const float s = ((a[0] + a[1]) + (a[2] + a[3])) + ((b[0] + b[1]) + (b[2] + b[3])) + ((c[0] + c[1]) + (c[2] + c[3])) + ((d[0] + d[1]) + (d[2] + d[3]));
            rsbuf[parity * 256 + tid] = __builtin_amdgcn_rsqf(s * (1.f / 1024.f) + EPS);
        }
    }
}

template <class Epi>
__device__ __forceinline__ void gemm_phase(LAS unsigned char* lds, LAS unsigned char* xl, const Gemm g, const StaticOrder& S, const Epi& E, const int tid) {
    const int wid = __builtin_amdgcn_readfirstlane(tid >> 6), lane = tid & 63, wr = wid >> 2, wc = wid & 3, fr = lane & 15, fq = lane >> 4;
    const int K = g.K, nt = K / BK;
    unsigned voffA[2], voffB[2];
#pragma unroll
    for (int i = 0; i < 2; ++i) { int R, C; stage_rc(tid * 16 + i * 8192, R, C); const int Rb = Epi::PERM ? ((R & ~31) + perm32(R & 31)) : R;
        voffA[i] = (unsigned)(R * g.lda + C) * 2u; voffB[i] = (unsigned)(Rb * g.ldb + C) * 2u; }
    const size_t kstep = (size_t)(BK * 2);
    const size_t hstepA = (size_t)HALF * g.lda * 2, hstepB = (size_t)HALF * g.ldb * 2, tstepA = 2 * hstepA, tstepB = 2 * hstepB;
    const unsigned ldsw = (unsigned)wid * 1024u, lds0 = (unsigned)(size_t)lds;
    const int aoff = lds_byte(wr * 64 + fr, fq * 8), boff = lds_byte(wc * 32 + fr, fq * 8);
    LAS float* rsbuf = (LAS float*)xl;
#define PG8_SA(b, h) (((b) * 2 + (h)) * HTB)
#define PG8_SB(b, h) ((4 + (b) * 2 + (h)) * HTB)
#define PG8_STAGE(bufoff, gbase, voff) do { _Pragma("unroll") for (int _i = 0; _i < 2; ++_i) \
        glds16_s((const void*)(gbase), (voff)[_i], (unsigned)__builtin_amdgcn_readfirstlane((int)(lds0 + (unsigned)(bufoff) + ldsw + _i * 8192))); } while (0)
#define PG8_LDA(dst, b, h) do { _Pragma("unroll") for (int m = 0; m < 4; ++m) _Pragma("unroll") for (int k = 0; k < 2; ++k) dst[m][k] = *(const LAS bf16x8*)(lds + PG8_SA(b, h) + aoff + m * 2048 + k * 1024); } while (0)
#define PG8_LDB(dst, b, h) do { _Pragma("unroll") for (int n = 0; n < 2; ++n) _Pragma("unroll") for (int k = 0; k < 2; ++k) dst[n][k] = *(const LAS bf16x8*)(lds + PG8_SB(b, h) + boff + n * 2048 + k * 1024); } while (0)
#define PG8_MMA(ai, bj, At, Bt) do { __builtin_amdgcn_s_setprio(1); _Pragma("unroll") for (int m = 0; m < 4; ++m) _Pragma("unroll") for (int n = 0; n < 2; ++n) _Pragma("unroll") for (int k = 0; k < 2; ++k) \
        acc[ai][bj][m][n] = __builtin_amdgcn_mfma_f32_16x16x32_bf16(Bt[n][k], At[m][k], acc[ai][bj][m][n], 0, 0, 0); __builtin_amdgcn_s_setprio(0); } while (0)
#define PG8_WAIT_V(n) asm volatile("s_waitcnt vmcnt(" #n ")" ::: "memory")
#define PG8_WAIT_L(n) asm volatile("s_waitcnt lgkmcnt(" #n ")" ::: "memory")
#define PG8_BAR __builtin_amdgcn_s_barrier()
#define PG8_SCHED __builtin_amdgcn_sched_barrier(0)
    Unit cur, nxt; int ui = 0;
    if (!S.next(0, cur)) return;
    rs_prep(E, cur, 0, rsbuf, tid);
    const char* cA = (const char*)g.A + (size_t)cur.pm * tstepA + (size_t)cur.pn * g.a_pn_off; const char* cB = (const char*)g.Bt + (size_t)cur.pn * tstepB;
    PG8_SCHED; PG8_STAGE(PG8_SB(0, 0), cB, voffB); PG8_SCHED; PG8_STAGE(PG8_SB(0, 1), cB + hstepB, voffB); PG8_SCHED; PG8_STAGE(PG8_SA(0, 0), cA, voffA); PG8_SCHED; PG8_STAGE(PG8_SA(0, 1), cA + hstepA, voffA); PG8_SCHED;
    if (wr == 1) PG8_BAR;
    PG8_WAIT_V(2); PG8_BAR;
    PG8_SCHED; PG8_STAGE(PG8_SB(1, 0), cB + kstep, voffB); PG8_SCHED; PG8_STAGE(PG8_SA(1, 0), cA + kstep, voffA); PG8_SCHED; PG8_STAGE(PG8_SB(1, 1), cB + hstepB + kstep, voffB); PG8_SCHED;
    PG8_WAIT_V(6); PG8_BAR;
    PG8_SCHED;
    Acc acc;
#pragma unroll
    for (int a = 0; a < 2; ++a)
#pragma unroll
        for (int b = 0; b < 2; ++b)
#pragma unroll
            for (int m = 0; m < 4; ++m)
#pragma unroll
                for (int n = 0; n < 2; ++n) acc[a][b][m][n] = (f32x4){0.f, 0.f, 0.f, 0.f};
    bf16x8 At[4][2], B0[2][2], B1[2][2];
    for (;;) {
        const bool has_next = S.next(ui + 1, nxt);
        const char* nA = has_next ? (const char*)g.A + (size_t)nxt.pm * tstepA + (size_t)nxt.pn * g.a_pn_off : cA; const char* nB = has_next ? (const char*)g.Bt + (size_t)nxt.pn * tstepB : cB;
        for (int t = 0; t < nt; t += 2) {
            const bool last = (t == nt - 2);
            const char* a1 = cA + (size_t)(t + 1) * kstep;
            const char* a2 = last ? nA : cA + (size_t)(t + 2) * kstep; const char* b2 = last ? nB : cB + (size_t)(t + 2) * kstep;
            const char* a3 = a2 + kstep; const char* b3 = b2 + kstep;
            PG8_LDB(B0, 0, 0); PG8_LDB(B1, 0, 1); PG8_SCHED; PG8_LDA(At, 0, 0); PG8_STAGE(PG8_SA(1, 1), a1 + hstepA, voffA);
            PG8_WAIT_V(8); PG8_WAIT_L(0); PG8_BAR; PG8_MMA(0, 0, At, B0); PG8_MMA(0, 1, At, B1); PG8_BAR; PG8_SCHED;
            PG8_LDA(At, 0, 1); PG8_STAGE(PG8_SB(0, 0), b2, voffB); PG8_STAGE(PG8_SB(0, 1), b2 + hstepB, voffB); PG8_STAGE(PG8_SA(0, 0), a2, voffA);
            PG8_WAIT_V(8); PG8_WAIT_L(0); PG8_BAR; PG8_MMA(1, 0, At, B0); PG8_MMA(1, 1, At, B1); PG8_BAR; PG8_SCHED;
            PG8_LDB(B0, 1, 0); PG8_LDB(B1, 1, 1); PG8_SCHED; PG8_LDA(At, 1, 0); PG8_STAGE(PG8_SA(0, 1), a2 + hstepA, voffA);
            PG8_WAIT_V(8); PG8_WAIT_L(0); PG8_BAR; PG8_MMA(0, 0, At, B0); PG8_MMA(0, 1, At, B1); PG8_BAR; PG8_SCHED;
            PG8_LDA(At, 1, 1); PG8_STAGE(PG8_SB(1, 0), b3, voffB); PG8_STAGE(PG8_SB(1, 1), b3 + hstepB, voffB); PG8_STAGE(PG8_SA(1, 0), a3, voffA);
            PG8_WAIT_V(8); PG8_WAIT_L(0); PG8_BAR; PG8_MMA(1, 0, At, B0); PG8_MMA(1, 1, At, B1); PG8_BAR; PG8_SCHED;
        }
        if (wr == 0) PG8_BAR;
        E(acc, cur, wr, wc, fr, fq, xl, rsbuf + (ui & 1) * 256, tid);
        if (!has_next) break;
        rs_prep(E, nxt, (ui + 1) & 1, rsbuf, tid);
#pragma unroll
        for (int a = 0; a < 2; ++a)
#pragma unroll
            for (int b = 0; b < 2; ++b)
#pragma unroll
                for (int m = 0; m < 4; ++m)
#pragma unroll
                    for (int n = 0; n < 2; ++n) acc[a][b][m][n] = (f32x4){0.f, 0.f, 0.f, 0.f};
        cur = nxt; cA = nA; cB = nB; ++ui;
        if (wr == 1) PG8_BAR;
    }
    PG8_WAIT_V(0);
    PG8_BAR;
}

template <class Epi>
__device__ __forceinline__ void gemm_k128_phase(LAS unsigned char* lds, LAS unsigned char* xl, const Gemm g, const StaticOrder& S, const Epi& E, const int tid) {
    const int wid = __builtin_amdgcn_readfirstlane(tid >> 6), lane = tid & 63, wr = wid >> 2, wc = wid & 3, fr = lane & 15, fq = lane >> 4;
    const size_t kstep = (size_t)(BK * 2);
    const size_t hstepA = (size_t)HALF * g.lda * 2, hstepB = (size_t)HALF * g.ldb * 2, tstepA = 2 * hstepA, tstepB = 2 * hstepB;
    const unsigned ldsw = (unsigned)wid * 1024u, lds0 = (unsigned)(size_t)lds;
    const int aoff = lds_byte(wr * 64 + fr, fq * 8), boff = lds_byte(wc * 32 + fr, fq * 8);
#define PG8_STAGE_ALL(uu) do { int t_ = tid; asm volatile("" : "+v"(t_)); unsigned vA[2], vB[2]; \
        _Pragma("unroll") for (int i = 0; i < 2; ++i) { int R, C; stage_rc(t_ * 16 + i * 8192, R, C); const int Rb = Epi::PERM ? ((R & ~31) + perm32(R & 31)) : R; const int Ra = (R & 64) | (4 * (R & 15) + ((R >> 4) & 3));     \
            vA[i] = (unsigned)(Ra * g.lda + C) * 2u; vB[i] = (unsigned)(Rb * g.ldb + C) * 2u; } \
        const char* pA = (const char*)g.A + (size_t)(uu).pm * tstepA + (size_t)(uu).pn * g.a_pn_off; const char* pB = (const char*)g.Bt + (size_t)(uu).pn * tstepB; \
        _Pragma("unroll") for (int b = 0; b < 2; ++b) _Pragma("unroll") for (int h = 0; h < 2; ++h) { PG8_STAGE(PG8_SA(b, h), pA + h * hstepA + b * kstep, vA); PG8_STAGE(PG8_SB(b, h), pB + h * hstepB + b * kstep, vB); } } while (0)
#define PG8_MMAH(bj, At, Bt) do { _Pragma("unroll") for (int m = 0; m < 4; ++m) _Pragma("unroll") for (int n = 0; n < 2; ++n) _Pragma("unroll") for (int k = 0; k < 2; ++k) \
        acc[bj][m][n] = __builtin_amdgcn_mfma_f32_16x16x32_bf16(Bt[n][k], At[m][k], acc[bj][m][n], 0, 0, 0); } while (0)
    Unit cur, nxt;
    if (!S.next(0, cur)) return;
    PG8_STAGE_ALL(cur);
    for (int ui = 0;; ++ui) {
        PG8_WAIT_V(0); PG8_BAR;
        const bool has_next = S.next(ui + 1, nxt);
#pragma unroll
        for (int ai = 0; ai < 2; ++ai) {
            AccH acc;
#pragma unroll
            for (int b = 0; b < 2; ++b)
#pragma unroll
                for (int m = 0; m < 4; ++m)
#pragma unroll
                    for (int n = 0; n < 2; ++n) acc[b][m][n] = (f32x4){0.f, 0.f, 0.f, 0.f};
            { bf16x8 At[4][2], B0[2][2], B1[2][2];
              PG8_LDB(B0, 0, 0); PG8_LDB(B1, 0, 1); PG8_LDA(At, 0, ai); PG8_WAIT_L(0); PG8_MMAH(0, At, B0); PG8_MMAH(1, At, B1);
              PG8_LDB(B0, 1, 0); PG8_LDB(B1, 1, 1); PG8_LDA(At, 1, ai); PG8_WAIT_L(0); PG8_MMAH(0, At, B0); PG8_MMAH(1, At, B1); }
            if (ai == 1) { PG8_BAR;
                if (has_next) PG8_STAGE_ALL(nxt); }
            PG8_SCHED;
            E.half(acc, cur, ai, wr, wc, fr, fq, xl, tid);
            PG8_SCHED;
        }
        if (!has_next) break;
        cur = nxt;
    }
    PG8_WAIT_V(0);
    PG8_BAR;
#undef PG8_MMAH
#undef PG8_STAGE_ALL
#undef PG8_SA
#undef PG8_SB
#undef PG8_STAGE
#undef PG8_LDA
#undef PG8_LDB
#undef PG8_MMA
#undef PG8_WAIT_V
#undef PG8_WAIT_L
#undef PG8_BAR
#undef PG8_SCHED
}

template <int MODE> struct EpiRowBf16 {
    static constexpr bool PERM = true; static constexpr int RS_MODE = 1;
    const float* ssq; bf16_t* O0; bf16_t* O1; int ldc;
    __device__ __forceinline__ void operator()(Acc& acc, const Unit& u, int wr, int wc, int fr, int fq, LAS unsigned char* xl, const LAS float* rs, int tid) const {
        asm volatile("" : "+v"(fr), "+v"(fq), "+v"(tid));
        bf16_t* base; int colt = u.pn * BM;
        if (MODE == 0) { if (colt >= D) { base = O1; colt -= D; } else base = O0; } else base = O0;
        const bool act_gelu = (MODE == 0) && (u.pn * BM < D);
        const int col0 = colt + wc * 32 + 8 * fq;
#pragma unroll
        for (int ai = 0; ai < 2; ++ai)
#pragma unroll
            for (int m = 0; m < 4; ++m) {
                const int rl = ai * HALF + wr * 64 + m * 16 + fr; const float r = rs[rl];
                bf16_t* rowp = base + (size_t)(u.pm * BM + rl) * ldc + col0;
#pragma unroll
                for (int bj = 0; bj < 2; ++bj) {
                    f32x4 v0 = acc[ai][bj][m][0] * r, v1 = acc[ai][bj][m][1] * r;
                    if (MODE == 0) { if (act_gelu) {
#pragma unroll
                        for (int j = 0; j < 4; ++j) { v0[j] = gelu_tanh(v0[j]); v1[j] = gelu_tanh(v1[j]); } } }
                    else {
#pragma unroll
                        for (int j = 0; j < 4; ++j) { const float a = fmaxf(v0[j], 0.f), b = fmaxf(v1[j], 0.f); v0[j] = a * a; v1[j] = b * b; } }
                    u32x4 w; w.x = cvt_pk_bf16(v0[0], v0[1]); w.y = cvt_pk_bf16(v0[2], v0[3]); w.z = cvt_pk_bf16(v1[0], v1[1]); w.w = cvt_pk_bf16(v1[2], v1[3]);
                    *(u32x4*)(rowp + bj * HALF) = w; }
                asm volatile("" ::: "memory"); __builtin_amdgcn_sched_barrier(0);
            }
    }
};
template <bool KP> struct EpiHead {
    static constexpr bool PERM = true; static constexpr int RS_MODE = 1;
    const float* ssq; bf16_t* O; const float* gain; float scale;
    __device__ __forceinline__ void operator()(Acc& acc, const Unit& u, int wr, int wc, int fr, int fq, LAS unsigned char* xl, const LAS float* rs, int tid) const {
        asm volatile("" : "+v"(fr), "+v"(fq), "+v"(tid));
        f32x4 gv[2][2];
#pragma unroll
        for (int bj = 0; bj < 2; ++bj)
#pragma unroll
            for (int n = 0; n < 2; ++n) gv[bj][n] = *(const f32x4*)(gain + 32 * bj + 8 * fq + 4 * n) * scale;
        const int col0 = u.pn * BM + 64 * wc + 8 * fq;
#pragma unroll
        for (int ai = 0; ai < 2; ++ai)
#pragma unroll
            for (int m = 0; m < 4; ++m) {
                const int rl = ai * HALF + wr * 64 + m * 16 + fr; const float r = rs[rl];
                float ss = 0.f;
#pragma unroll
                for (int bj = 0; bj < 2; ++bj)
#pragma unroll
                    for (int n = 0; n < 2; ++n) { acc[ai][bj][m][n] = acc[ai][bj][m][n] * r; const f32x4 x = acc[ai][bj][m][n]; ss += (x[0] * x[0] + x[1] * x[1]) + (x[2] * x[2] + x[3] * x[3]); }
                ss += __shfl_xor(ss, 16); ss += __shfl_xor(ss, 32);
                const float hr = __builtin_amdgcn_rsqf(ss * (1.f / 64.f) + EPS);
                bf16_t* rowp;
                if (KP) { const int row = u.pm * BM + rl, b = row / SEQ, s = row % SEQ, k5 = s & 31, rho = (k5 & 0x13) | ((k5 & 4) << 1) | ((k5 & 8) >> 1);
                    rowp = O + ((size_t)((b * NH + 4 * u.pn + wc) * (SEQ / 32) + (s >> 5)) * 4 * 64 + (size_t)((fq >> 1) * 64 + 32 * (fq & 1) + rho)) * 8; }
                else rowp = O + (size_t)(u.pm * BM + rl) * D + col0;
#pragma unroll
                for (int bj = 0; bj < 2; ++bj) { const f32x4 v0 = acc[ai][bj][m][0] * hr * gv[bj][0], v1 = acc[ai][bj][m][1] * hr * gv[bj][1];
                    u32x4 w; w.x = cvt_pk_bf16(v0[0], v0[1]); w.y = cvt_pk_bf16(v0[2], v0[3]); w.z = cvt_pk_bf16(v1[0], v1[1]); w.w = cvt_pk_bf16(v1[2], v1[3]);
                    *(u32x4*)(rowp + (KP ? 2 * 64 * 8 * bj : 32 * bj)) = w; }
                asm volatile("" ::: "memory"); __builtin_amdgcn_sched_barrier(0);
            }
    }
};
struct EpiVT {
    static constexpr bool PERM = true; static constexpr int RS_MODE = 2;
    const float* ssq; bf16_t* O;
    __device__ __forceinline__ void operator()(Acc& acc, const Unit& u, int wr, int wc, int fr, int fq, LAS unsigned char* xl, const LAS float* rs, int tid) const {
        asm volatile("" : "+v"(fr), "+v"(fq), "+v"(tid));
        f32x4 rv[2][2];
#pragma unroll
        for (int bj = 0; bj < 2; ++bj)
#pragma unroll
            for (int n = 0; n < 2; ++n) rv[bj][n] = *(const LAS f32x4*)(rs + bj * HALF + wc * 32 + 8 * fq + 4 * n);
        const int col0 = u.pn * BM + wc * 32 + 8 * fq;
#pragma unroll
        for (int ai = 0; ai < 2; ++ai)
#pragma unroll
            for (int m = 0; m < 4; ++m) {
                const int f = u.pm * BM + ai * HALF + wr * 64 + m * 16 + fr, hh = f >> 6, dd = f & 63;
#pragma unroll
                for (int bj = 0; bj < 2; ++bj) { const f32x4 v0 = acc[ai][bj][m][0] * rv[bj][0], v1 = acc[ai][bj][m][1] * rv[bj][1];
                    u32x4 w; w.x = cvt_pk_bf16(v0[0], v0[1]); w.y = cvt_pk_bf16(v0[2], v0[3]); w.z = cvt_pk_bf16(v1[0], v1[1]); w.w = cvt_pk_bf16(v1[2], v1[3]);
                    const int t0 = col0 + bj * HALF, b = t0 / SEQ, s = t0 % SEQ;
                    bf16_t* p = O + ((size_t)((b * NH + hh) * (SEQ / 64) + (s >> 6)) * 8 * 64 + (size_t)(((dd >> 5) * 4 + ((s >> 4) & 3)) * 64 + 32 * ((s >> 3) & 1) + (dd & 31))) * 8;
                    *(u32x4*)p = w; }
                asm volatile("" ::: "memory"); __builtin_amdgcn_sched_barrier(0);
            }
    }
};
struct EpiResid {
    static constexpr bool PERM = true; static constexpr int RS_MODE = 0;
    const float* ssq; float* out; bf16_t* hb; float* ssq_out; int last;
    __device__ __forceinline__ void operator()(Acc& acc, const Unit& u, int wr, int wc, int fr, int fq, LAS unsigned char* xl, const LAS float* rs, int tid) const {
        asm volatile("" : "+v"(fr), "+v"(fq), "+v"(tid));
        const int col0 = u.pn * BM + wc * 32 + 8 * fq;
#pragma unroll
        for (int ai = 0; ai < 2; ++ai) {
            float ssm[4];
            u32x4 bsr[4][2];
#pragma unroll
            for (int m = 0; m < 4; ++m)
#pragma unroll
                for (int bj = 0; bj < 2; ++bj) bsr[m][bj] = *(const u32x4*)(hb + (size_t)(u.pm * BM + ai * HALF + wr * 64 + m * 16 + fr) * D + col0 + bj * HALF);
#pragma unroll
            for (int m = 0; m < 4; ++m) {
                const int row = u.pm * BM + ai * HALF + wr * 64 + m * 16 + fr; const size_t off = (size_t)row * D + col0;
                float ss = 0.f;
#pragma unroll
                for (int bj = 0; bj < 2; ++bj) {
                    const u32x4 b = bsr[m][bj];
                    const f32x4 o0 = (f32x4){bf_lo(b.x), bf_hi(b.x), bf_lo(b.y), bf_hi(b.y)} + acc[ai][bj][m][0], o1 = (f32x4){bf_lo(b.z), bf_hi(b.z), bf_lo(b.w), bf_hi(b.w)} + acc[ai][bj][m][1];
                    if (last) { *(f32x4*)(out + off + bj * HALF) = o0; *(f32x4*)(out + off + bj * HALF + 4) = o1; }
                    else { ss += ((o0[0] * o0[0] + o0[1] * o0[1]) + (o0[2] * o0[2] + o0[3] * o0[3])) + ((o1[0] * o1[0] + o1[1] * o1[1]) + (o1[2] * o1[2] + o1[3] * o1[3]));
                        u32x4 w; w.x = cvt_pk_bf16(o0[0], o0[1]); w.y = cvt_pk_bf16(o0[2], o0[3]); w.z = cvt_pk_bf16(o1[0], o1[1]); w.w = cvt_pk_bf16(o1[2], o1[3]); *(u32x4*)(hb + off + bj * HALF) = w; }
                }
                if (!last) { ss += __shfl_xor(ss, 16); ss += __shfl_xor(ss, 32); ssm[m] = ss; }
            }
            if (!last) {
                const float sv = fq == 0 ? ssm[0] : fq == 1 ? ssm[1] : fq == 2 ? ssm[2] : ssm[3];
                ssq_out[(size_t)(u.pm * BM + ai * HALF + wr * 64 + fq * 16 + fr) * 16 + u.pn * 4 + wc] = sv; }
            asm volatile("" ::: "memory");
        }
    }
};

__device__ __forceinline__ void scan16_pair(float& a0, float& b0, float& a1, float& b1) {
    asm volatile(
        "s_nop 1\n\t"
        "v_fmac_f32_dpp %1, %1, %0 row_shr:1 row_mask:0xf bank_mask:0xf\n\t"
        "v_fmac_f32_dpp %3, %3, %2 row_shr:1 row_mask:0xf bank_mask:0xf\n\t"
        "v_mul_f32_dpp %0, %0, %0 row_shr:1 row_mask:0xf bank_mask:0xf\n\t"
        "v_mul_f32_dpp %2, %2, %2 row_shr:1 row_mask:0xf bank_mask:0xf\n\t"
        "v_fmac_f32_dpp %1, %1, %0 row_shr:2 row_mask:0xf bank_mask:0xf\n\t"
        "v_fmac_f32_dpp %3, %3, %2 row_shr:2 row_mask:0xf bank_mask:0xf\n\t"
        "v_mul_f32_dpp %0, %0, %0 row_shr:2 row_mask:0xf bank_mask:0xf\n\t"
        "v_mul_f32_dpp %2, %2, %2 row_shr:2 row_mask:0xf bank_mask:0xf\n\t"
        "v_fmac_f32_dpp %1, %1, %0 row_shr:4 row_mask:0xf bank_mask:0xf\n\t"
        "v_fmac_f32_dpp %3, %3, %2 row_shr:4 row_mask:0xf bank_mask:0xf\n\t"
        "v_mul_f32_dpp %0, %0, %0 row_shr:4 row_mask:0xf bank_mask:0xf\n\t"
        "v_mul_f32_dpp %2, %2, %2 row_shr:4 row_mask:0xf bank_mask:0xf\n\t"
        "v_fmac_f32_dpp %1, %1, %0 row_shr:8 row_mask:0xf bank_mask:0xf\n\t"
        "v_fmac_f32_dpp %3, %3, %2 row_shr:8 row_mask:0xf bank_mask:0xf\n\t"
        "v_mul_f32_dpp %0, %0, %0 row_shr:8 row_mask:0xf bank_mask:0xf\n\t"
        "v_mul_f32_dpp %2, %2, %2 row_shr:8 row_mask:0xf bank_mask:0xf\n\t"
        "s_nop 1"
        : "+v"(a0), "+v"(b0), "+v"(a1), "+v"(b1));
}
struct EpiGate {
    static constexpr bool PERM = true; static constexpr int RS_MODE = 0;
    const float* ssq; int mode; const bf16_t* rec; const bf16_t* gate; bf16_t* Y; const float* bg; const float* SP8; float* SA; float* SB;
    __device__ __forceinline__ void half(AccH& acc, const Unit& u, const int ai, int wr, int wc, int fr, int fq, LAS unsigned char* xl, int tid) const {
        asm volatile("" : "+v"(fr), "+v"(fq), "+v"(tid));
        LAS f32x2* seg = (LAS f32x2*)(xl + 2048);
        LAS f32x2* part = (LAS f32x2*)(xl + 2048 + 4096);
        const int ch0 = 32 * wc + 8 * fq, cg0 = 128 * u.pn + ch0;
        const unsigned boff = (unsigned)((u.pm * BM + ai * HALF + wr * 64 + 4 * fr) * D + cg0) * 2u;
        if (mode == 2) { asm volatile("s_waitcnt lgkmcnt(0)\n\ts_barrier" ::: "memory"); return; }
        u32x4 xrr[4];
#pragma unroll
        for (int m = 0; m < 4; ++m) xrr[m] = *(const u32x4*)((const char*)rec + (boff + (unsigned)(m * D * 2)));
        if (mode == 1 && ai == 0) {
            const int j = u.pm & 63, pb = u.pm - j, ch = tid & 127, p = tid >> 7;
            float ca = 1.f, cb = 0.f;
            float Av[16], Bv[16];
#pragma unroll
            for (int i = 0; i < 16; ++i) { const int jj = 16 * p + i; const bool ok = jj < j; const size_t o = (size_t)(pb + (ok ? jj : 0)) * D + 128 * u.pn + ch;
                const float av = SA[o], bv = SB[o]; Av[i] = ok ? av : 1.f; Bv[i] = ok ? bv : 0.f; }
#pragma unroll
            for (int i = 0; i < 16; ++i) { cb = Bv[i] + Av[i] * cb; ca *= Av[i]; }
            part[p * 128 + ch] = (f32x2){ca, cb};
            asm volatile("" ::: "memory"); __builtin_amdgcn_sched_barrier(0);
        }
#pragma unroll
        for (int n = 0; n < 2; ++n) {
            const f32x4 sp8 = *(const f32x4*)(SP8 + cg0 + 4 * n);
            const f32x4 bR = *(const f32x4*)(bg + 256 * u.pn + ch0 + 4 * n) * (-LOG2E), bI = *(const f32x4*)(bg + 256 * u.pn + 128 + ch0 + 4 * n) * (-LOG2E);
#pragma unroll
            for (int m = 0; m < 4; ++m) {
                const unsigned xa = n ? xrr[m].z : xrr[m].x, xb = n ? xrr[m].w : xrr[m].y;
                const float xv[4] = {bf_lo(xa), bf_hi(xa), bf_lo(xb), bf_hi(xb)};
                float av[4], bv[4];
#pragma unroll
                for (int jp = 0; jp < 2; ++jp) {
                    const f32x2 aR = (f32x2){acc[0][m][n][2 * jp], acc[0][m][n][2 * jp + 1]}, aI = (f32x2){acc[1][m][n][2 * jp], acc[1][m][n][2 * jp + 1]};
                    const f32x2 tR = aR * (-LOG2E) + (f32x2){bR[2 * jp], bR[2 * jp + 1]}, tI = aI * (-LOG2E) + (f32x2){bI[2 * jp], bI[2 * jp + 1]};
                    const f32x2 dR = (f32x2){fast_exp2(tR.x), fast_exp2(tR.y)} + 1.f, dI = (f32x2){fast_exp2(tI.x), fast_exp2(tI.y)} + 1.f;
                    const f32x2 dd = dR * dI;
                    const f32x2 inv = (f32x2){fast_rcp(dd.x), fast_rcp(dd.y)};
                    const f32x2 rg = inv * dI, ig = inv * dR;
                    const f32x2 la2 = rg * (f32x2){-sp8[2 * jp], -sp8[2 * jp + 1]};
                    const f32x2 a = (f32x2){fast_exp2(la2.x), fast_exp2(la2.y)}, x2 = la2 * (2.f / LOG2E);
                    const f32x2 pq = -x2 * (x2 * (x2 * (x2 * 0.041666668f + 0.16666667f) + 0.5f) + 1.f), qq = 1.f - a * a;
                    const f32x2 om = (f32x2){(x2.x > -0.02f) ? pq.x : qq.x, (x2.y > -0.02f) ? pq.y : qq.y};
                    const f32x2 bb = (f32x2){__builtin_amdgcn_sqrtf(om.x), __builtin_amdgcn_sqrtf(om.y)} * ig * (f32x2){xv[2 * jp], xv[2 * jp + 1]};
                    av[2 * jp] = a.x; av[2 * jp + 1] = a.y; bv[2 * jp] = bb.x; bv[2 * jp + 1] = bb.y;
                }
#pragma unroll
                for (int j = 0; j < 4; ++j) { acc[0][m][n][j] = av[j]; acc[1][m][n][j] = bv[j]; }
                asm volatile("" ::: "memory"); __builtin_amdgcn_sched_barrier(0);
            }
        }
#pragma unroll
        for (int n = 0; n < 2; ++n) {
            float ta[4], tb[4];
#pragma unroll
            for (int j = 0; j < 4; ++j) {
#pragma unroll
                for (int m = 1; m < 4; ++m) { acc[1][m][n][j] = acc[0][m][n][j] * acc[1][m - 1][n][j] + acc[1][m][n][j]; acc[0][m][n][j] = acc[0][m][n][j] * acc[0][m - 1][n][j]; }
                ta[j] = acc[0][3][n][j]; tb[j] = acc[1][3][n][j];
            }
            scan16_pair(ta[0], tb[0], ta[1], tb[1]); scan16_pair(ta[2], tb[2], ta[3], tb[3]);
#pragma unroll
            for (int j = 0; j < 4; ++j) {
                if (fr == 15) seg[(2 * ai + wr) * 128 + ch0 + 4 * n + j] = (f32x2){ta[j], tb[j]};
                const float ea = __int_as_float(__builtin_amdgcn_update_dpp(__float_as_int(1.f), __float_as_int(ta[j]), 0x111, 0xf, 0xf, false));
                const float eb = __int_as_float(__builtin_amdgcn_update_dpp(__float_as_int(0.f), __float_as_int(tb[j]), 0x111, 0xf, 0xf, false));
#pragma unroll
                for (int m = 0; m < 4; ++m) { acc[1][m][n][j] = acc[1][m][n][j] + acc[0][m][n][j] * eb; acc[0][m][n][j] = acc[0][m][n][j] * ea; }
            }
            asm volatile("" ::: "memory"); __builtin_amdgcn_sched_barrier(0);
        }
        u32x4 grr[4];
        if (mode == 1) {
#pragma unroll
            for (int m = 0; m < 4; ++m) grr[m] = *(const u32x4*)((const char*)gate + (boff + (unsigned)(m * D * 2)));
        }
        if (!(mode == 0 && ai == 0)) asm volatile("s_waitcnt lgkmcnt(0)\n\ts_barrier" ::: "memory");
        if (mode == 0) {
            if (ai == 1 && tid < 128) { float A = 1.f, B = 0.f;
#pragma unroll
                for (int s = 0; s < 4; ++s) { const f32x2 v = seg[s * 128 + tid]; B = v.y + v.x * B; A *= v.x; }
                SA[(size_t)u.pm * D + 128 * u.pn + tid] = A; SB[(size_t)u.pm * D + 128 * u.pn + tid] = B; }
        } else {
            const int sme = 2 * ai + wr;
#pragma unroll
            for (int n = 0; n < 2; ++n) {
#pragma unroll
                for (int j = 0; j < 4; ++j) {
                    const int ch = ch0 + 4 * n + j;
                    float c = 0.f;
#pragma unroll
                    for (int p = 0; p < 4; ++p) { const f32x2 v = part[p * 128 + ch]; c = v.y + v.x * c; }
#pragma unroll
                    for (int s = 0; s < 3; ++s) { if (s < 2 * ai + 1) { const f32x2 v = seg[s * 128 + ch]; const float cn = v.y + v.x * c; c = (s < sme) ? cn : c; } }
#pragma unroll
                    for (int m = 0; m < 4; ++m) acc[1][m][n][j] = acc[1][m][n][j] + acc[0][m][n][j] * c;
                    asm volatile("" ::: "memory"); __builtin_amdgcn_sched_barrier(0);
                }
            }
#pragma unroll
            for (int m = 0; m < 4; ++m) {
                unsigned bo = boff; asm volatile("" : "+v"(bo));
                const u32x4 gr = grr[m]; const f32x4 h0 = acc[1][m][0], h1 = acc[1][m][1];
                u32x4 w; w.x = cvt_pk_bf16(bf_lo(gr.x) * h0[0], bf_hi(gr.x) * h0[1]); w.y = cvt_pk_bf16(bf_lo(gr.y) * h0[2], bf_hi(gr.y) * h0[3]);
                w.z = cvt_pk_bf16(bf_lo(gr.z) * h1[0], bf_hi(gr.z) * h1[1]); w.w = cvt_pk_bf16(bf_lo(gr.w) * h1[2], bf_hi(gr.w) * h1[3]);
                *(u32x4*)((char*)Y + (bo + (unsigned)(m * D * 2))) = w;
                asm volatile("" ::: "memory"); __builtin_amdgcn_sched_barrier(0);
            }
        }
    }
};
}

__device__ __forceinline__ int crow(int r, int hi) { return (r & 3) + 8 * (r >> 2) + 4 * hi; }
__device__ __forceinline__ void attn_unit(int b, int h, int chunk, int half, const bf16_t* Q, const bf16_t* __restrict__ Kb, const bf16_t* __restrict__ VT, bf16_t* O,
                                          const float* __restrict__ rel_bias, LAS float* wscr, int lane) {
    const int r32 = lane & 31, hi = lane >> 5;
    const long row0 = (long)b * SEQ + 64 * chunk + 32 * half;
    bf16x8 qr[4];
    const char* qbp = (const char*)(Q + row0 * D + 64 * h);
    const unsigned qoff = (unsigned)(r32 * D + 8 * hi) * 2u, l16 = (unsigned)lane * 16u;
#pragma unroll
    for (int d0 = 0; d0 < 4; ++d0) qr[d0] = *(const bf16x8*)(qbp + (qoff + 32u * d0));
    f32x16 o0, o1;
#pragma unroll
    for (int r = 0; r < 16; ++r) { o0[r] = 0.f; o1[r] = 0.f; }
    float mhat = 0.f, l = 0.f;
    f32x16 negm;
#pragma unroll
    for (int r = 0; r < 16; ++r) negm[r] = 0.f;
    asm volatile("" : "+v"(negm));
    const int t0 = chunk < 8 ? 8 - chunk : 0;
    const char* kbp = (const char*)Kb + (size_t)(b * NH + h) * (SEQ / 32) * 4 * 1024 + (long)(chunk - 8) * 8 * 1024;
    const char* vbp = (const char*)VT + (size_t)(b * NH + h) * (SEQ / 64) * 8 * 1024 + (long)(chunk - 8) * 8 * 1024;
    LAS float* wb = wscr + 64;
    { const float* bias_h = rel_bias + h * NREL;
      const float cb = bias_h[NREL - 1];
#pragma unroll
      for (int i = 0; i < 4; ++i) { const int idx = lane + 64 * i; wb[idx] = (bias_h[idx < NREL - 1 ? idx : NREL - 1] - cb) * LOG2E; }
      asm volatile("s_waitcnt lgkmcnt(0)" ::: "memory"); }
    const int qi = 32 * half + r32;
    const int rot = (chunk >= 8) ? (17 - chunk % 9) % 9 : 0;
    bf16x8 kf[2][4];
    { const int tf = (t0 + rot) % 9;
#pragma unroll
      for (int kh = 0; kh < 2; ++kh)
#pragma unroll
          for (int d0 = 0; d0 < 4; ++d0) kf[kh][d0] = *(const bf16x8*)(kbp + (size_t)((tf * 2 + kh) * 4 + d0) * 1024 + l16); }
    for (int s = t0; s < 9; ++s) {
        const int t = (s + rot) % 9;
        bf16x8 vf[2][2][2];
#pragma unroll
        for (int dh = 0; dh < 2; ++dh)
#pragma unroll
            for (int kh = 0; kh < 2; ++kh)
#pragma unroll
                for (int sl = 0; sl < 2; ++sl) vf[dh][kh][sl] = *(const bf16x8*)(vbp + (size_t)(t * 8 + dh * 4 + kh * 2 + sl) * 1024 + l16);
        f32x16 p0, p1;
        p0 = __builtin_amdgcn_mfma_f32_32x32x16_bf16(kf[0][0], qr[0], negm, 0, 0, 0); p1 = __builtin_amdgcn_mfma_f32_32x32x16_bf16(kf[1][0], qr[0], negm, 0, 0, 0);
#pragma unroll
        for (int d0 = 1; d0 < 4; ++d0) { p0 = __builtin_amdgcn_mfma_f32_32x32x16_bf16(kf[0][d0], qr[d0], p0, 0, 0, 0); p1 = __builtin_amdgcn_mfma_f32_32x32x16_bf16(kf[1][d0], qr[d0], p1, 0, 0, 0); }
        { const int tn = s < 8 ? (s + 1 + rot) % 9 : t;
          __builtin_amdgcn_sched_barrier(0);
#pragma unroll
          for (int kh = 0; kh < 2; ++kh)
#pragma unroll
              for (int d0 = 0; d0 < 4; ++d0) kf[kh][d0] = *(const bf16x8*)(kbp + (size_t)((tn * 2 + kh) * 4 + d0) * 1024 + l16);
          __builtin_amdgcn_sched_barrier(0); }
        if (t > 5) {
            const LAS float* wq = wb + (qi + 64 * (8 - t) - 8 * hi + 63);
#pragma unroll
            for (int r = 0; r < 16; ++r) { const int kk = 16 * (r >> 3) + (r & 7); p0[r] += wq[-kk]; p1[r] += wq[-kk - 32]; }
        }
        float rm;
        { float ma = fmaxf(fmaxf(p0[0], p0[1]), p1[0]), mb = fmaxf(fmaxf(p0[2], p0[3]), p1[1]); ma = fmaxf(fmaxf(ma, p1[2]), p1[3]);
#pragma unroll
          for (int r = 4; r < 16; r += 4) { ma = fmaxf(fmaxf(ma, p0[r]), p0[r + 1]); mb = fmaxf(fmaxf(mb, p0[r + 2]), p0[r + 3]); ma = fmaxf(fmaxf(ma, p1[r]), p1[r + 1]); mb = fmaxf(fmaxf(mb, p1[r + 2]), p1[r + 3]); }
          rm = fmaxf(ma, mb); }
        rm = fmaxf(rm, __shfl_xor(rm, 32));
        if (s == t0 || __any(rm > 8.f)) {
            const float dl = (s == t0) ? rm : fmaxf(rm, 0.f), alpha = fast_exp2(-dl);
            mhat += dl; l *= alpha;
#pragma unroll
            for (int r = 0; r < 16; ++r) { p0[r] -= dl; p1[r] -= dl; negm[r] = -mhat; }
            asm volatile("" : "+v"(negm));
            if (hi == 0) wscr[r32] = alpha;
            asm volatile("s_waitcnt lgkmcnt(0)" ::: "memory");
#pragma unroll
            for (int r = 0; r < 16; ++r) { const float al = wscr[crow(r, hi)]; o0[r] *= al; o1[r] *= al; }
            asm volatile("s_waitcnt lgkmcnt(0)" ::: "memory");
        }
#pragma unroll
        for (int r = 0; r < 16; ++r) { p0[r] = fast_exp2(p0[r]); p1[r] = fast_exp2(p1[r]); }
        { const f32x16 sv = p0 + p1;
          typedef float f32x8 __attribute__((ext_vector_type(8)));
          const f32x8 s8 = sv.lo + sv.hi; const f32x4 s4 = s8.lo + s8.hi; const f32x2 s2 = s4.lo + s4.hi;
          l += s2.x + s2.y; }
        bf16x8 pa[2][2];
#pragma unroll
        for (int sl = 0; sl < 2; ++sl) {
            u32x4 w0, w1;
            w0.x = cvt_pk_bf16(p0[8 * sl + 0], p0[8 * sl + 1]); w0.y = cvt_pk_bf16(p0[8 * sl + 2], p0[8 * sl + 3]); w0.z = cvt_pk_bf16(p0[8 * sl + 4], p0[8 * sl + 5]); w0.w = cvt_pk_bf16(p0[8 * sl + 6], p0[8 * sl + 7]);
            w1.x = cvt_pk_bf16(p1[8 * sl + 0], p1[8 * sl + 1]); w1.y = cvt_pk_bf16(p1[8 * sl + 2], p1[8 * sl + 3]); w1.z = cvt_pk_bf16(p1[8 * sl + 4], p1[8 * sl + 5]); w1.w = cvt_pk_bf16(p1[8 * sl + 6], p1[8 * sl + 7]);
            pa[0][sl] = __builtin_bit_cast(bf16x8, w0); pa[1][sl] = __builtin_bit_cast(bf16x8, w1);
        }
#pragma unroll
        for (int kh = 0; kh < 2; ++kh)
#pragma unroll
            for (int sl = 0; sl < 2; ++sl) {
                o0 = __builtin_amdgcn_mfma_f32_32x32x16_bf16(pa[kh][sl], vf[0][kh][sl], o0, 0, 0, 0);
                o1 = __builtin_amdgcn_mfma_f32_32x32x16_bf16(pa[kh][sl], vf[1][kh][sl], o1, 0, 0, 0);
            }
    }
    l += __shfl_xor(l, 32);
    if (hi == 0) wscr[r32] = 1.0f / l;
    asm volatile("s_waitcnt lgkmcnt(0)" ::: "memory");
    char* obp = (char*)(O + row0 * D + 64 * h);
    const unsigned ooff = (unsigned)(4 * hi * D + r32) * 2u;
#pragma unroll
    for (int r = 0; r < 16; ++r) { const int q = crow(r, hi); const float il = wscr[q];
        const unsigned w0 = cvt_pk_bf16(o0[r] * il, 0.f), w1 = cvt_pk_bf16(o1[r] * il, 0.f);
        *(bf16_t*)(obp + (size_t)(((r & 3) + 8 * (r >> 2)) * D * 2) + ooff) = (bf16_t)w0; *(bf16_t*)(obp + (size_t)(((r & 3) + 8 * (r >> 2)) * D * 2 + 64) + ooff) = (bf16_t)w1; }
    asm volatile("s_waitcnt lgkmcnt(0)" ::: "memory");
}

__device__ __forceinline__ void attn_half(f32x16& p0, f32x16& p1, f32x16& o0, f32x16& o1, float& mhat, float& l, const bf16x8 (&vf)[2][2][2],
                                          const bool first, const int t, const int qi, const int hi, const int r32, LAS float* wscr, const LAS float* wb) {
    if (t > 5) {
        const LAS float* wq = wb + (qi + 64 * (8 - t) - 8 * hi + 63);
#pragma unroll
        for (int r = 0; r < 16; ++r) { const int kk = 16 * (r >> 3) + (r & 7); p0[r] += wq[-kk]; p1[r] += wq[-kk - 32]; }
    }
    float rm;
    { float ma = fmaxf(fmaxf(p0[0], p0[1]), p1[0]), mb = fmaxf(fmaxf(p0[2], p0[3]), p1[1]); ma = fmaxf(fmaxf(ma, p1[2]), p1[3]);
#pragma unroll
      for (int r = 4; r < 16; r += 4) { ma = fmaxf(fmaxf(ma, p0[r]), p0[r + 1]); mb = fmaxf(fmaxf(mb, p0[r + 2]), p0[r + 3]); ma = fmaxf(fmaxf(ma, p1[r]), p1[r + 1]); mb = fmaxf(fmaxf(mb, p1[r + 2]), p1[r + 3]); }
      rm = fmaxf(ma, mb); }
    rm = fmaxf(rm, __shfl_xor(rm, 32)) - mhat;
    if (__any(rm > 64.f || (first && rm < -64.f))) {
        const float dl = first ? rm : fmaxf(rm, 0.f), alpha = first ? 1.f : fast_exp2(-dl);
        mhat += dl; l *= alpha;
        if (hi == 0) wscr[r32] = alpha;
        asm volatile("s_waitcnt lgkmcnt(0)" ::: "memory");
#pragma unroll
        for (int r = 0; r < 16; ++r) { const float al = wscr[crow(r, hi)]; o0[r] *= al; o1[r] *= al; }
        asm volatile("s_waitcnt lgkmcnt(0)" ::: "memory");
    }
    if (__any(mhat != 0.f)) {
#pragma unroll
        for (int r = 0; r < 16; ++r) { p0[r] -= mhat; p1[r] -= mhat; }
    }
    float ls = 0.f;
#define ATTN_SLAB(P, KH, SL) do { \
        float e_[8]; _Pragma("unroll") for (int j = 0; j < 8; ++j) e_[j] = fast_exp2(P[8 * (SL) + j]); \
        ls += ((e_[0] + e_[1]) + (e_[2] + e_[3])) + ((e_[4] + e_[5]) + (e_[6] + e_[7])); \
        u32x4 w_; w_.x = cvt_pk_bf16(e_[0], e_[1]); w_.y = cvt_pk_bf16(e_[2], e_[3]); w_.z = cvt_pk_bf16(e_[4], e_[5]); w_.w = cvt_pk_bf16(e_[6], e_[7]); \
        const bf16x8 pa_ = __builtin_bit_cast(bf16x8, w_); \
        o0 = __builtin_amdgcn_mfma_f32_32x32x16_bf16(pa_, vf[0][KH][SL], o0, 0, 0, 0); \
        o1 = __builtin_amdgcn_mfma_f32_32x32x16_bf16(pa_, vf[1][KH][SL], o1, 0, 0, 0); \
        __builtin_amdgcn_sched_barrier(0); } while (0)
    ATTN_SLAB(p0, 0, 0); ATTN_SLAB(p0, 0, 1); ATTN_SLAB(p1, 1, 0); ATTN_SLAB(p1, 1, 1);
#undef ATTN_SLAB
    l += ls;
}
__device__ __forceinline__ void attn_store_half(const f32x16& o0, const f32x16& o1, float l, char* obp, const int hi, const int r32, LAS float* wscr) {
    l += __shfl_xor(l, 32);
    if (hi == 0) wscr[r32] = 1.0f / l;
    asm volatile("s_waitcnt lgkmcnt(0)" ::: "memory");
    const unsigned ooff = (unsigned)(4 * hi * D + r32) * 2u;
#pragma unroll
    for (int r = 0; r < 16; ++r) { const int q = crow(r, hi); const float il = wscr[q];
        const unsigned w0 = cvt_pk_bf16(o0[r] * il, 0.f), w1 = cvt_pk_bf16(o1[r] * il, 0.f);
        *(bf16_t*)(obp + (size_t)(((r & 3) + 8 * (r >> 2)) * D * 2) + ooff) = (bf16_t)w0; *(bf16_t*)(obp + (size_t)(((r & 3) + 8 * (r >> 2)) * D * 2 + 64) + ooff) = (bf16_t)w1; }
    asm volatile("s_waitcnt lgkmcnt(0)" ::: "memory");
}
__device__ __forceinline__ void attn_unit64(int b, int h, int chunk, const bf16_t* Q, const bf16_t* __restrict__ Kb, const bf16_t* __restrict__ VT, bf16_t* O,
                                            const float* __restrict__ rel_bias, LAS float* wscr, LAS bf16x8* qlds, int lane) {
    asm volatile("" : "+v"(lane));
    const int r32 = lane & 31, hi = lane >> 5;
    const long row0 = (long)b * SEQ + 64 * chunk;
    const char* qbp = (const char*)(Q + row0 * D + 64 * h);
    const unsigned qoff = (unsigned)(r32 * D + 8 * hi) * 2u, l16 = (unsigned)lane * 16u;
#pragma unroll
    for (int hf = 0; hf < 2; ++hf)
#pragma unroll
        for (int d0 = 0; d0 < 4; ++d0) qlds[(hf * 4 + d0) * 64 + lane] = *(const bf16x8*)(qbp + (size_t)(hf * 32 * D * 2) + (qoff + 32u * d0));
    f32x16 oA0, oA1, oB0, oB1;
#pragma unroll
    for (int r = 0; r < 16; ++r) { oA0[r] = 0.f; oA1[r] = 0.f; oB0[r] = 0.f; oB1[r] = 0.f; }
    float mhatA = 0.f, lA = 0.f, mhatB = 0.f, lB = 0.f;
    const int t0 = chunk < 8 ? 8 - chunk : 0;
    const char* kbp = (const char*)Kb + (size_t)(b * NH + h) * (SEQ / 32) * 4 * 1024 + (long)(chunk - 8) * 8 * 1024;
    const char* vbp = (const char*)VT + (size_t)(b * NH + h) * (SEQ / 64) * 8 * 1024 + (long)(chunk - 8) * 8 * 1024;
    LAS float* wb = wscr + 64;
    { const float* bias_h = rel_bias + h * NREL;
      const float cb = bias_h[NREL - 1];
#pragma unroll
      for (int i = 0; i < 4; ++i) { const int idx = lane + 64 * i; const unsigned bo = (unsigned)(idx < NREL - 1 ? idx : NREL - 1) * 4u; wb[idx] = (*(const float*)((const char*)bias_h + bo) - cb) * LOG2E; }
      asm volatile("s_waitcnt lgkmcnt(0)" ::: "memory"); }
    const int rot = (chunk >= 8) ? (17 - chunk % 9) % 9 : 0;
    bf16x8 kf[2][4];
    { const int tf = (t0 + rot) % 9;
#pragma unroll
      for (int kh = 0; kh < 2; ++kh)
#pragma unroll
          for (int d0 = 0; d0 < 4; ++d0) kf[kh][d0] = *(const bf16x8*)(kbp + (size_t)((tf * 2 + kh) * 4 + d0) * 1024 + l16); }
    for (int s = t0; s < 9; ++s) {
        const int t = (s + rot) % 9;
        bf16x8 vf[2][2][2];
#pragma unroll
        for (int dh = 0; dh < 2; ++dh)
#pragma unroll
            for (int kh = 0; kh < 2; ++kh)
#pragma unroll
                for (int sl = 0; sl < 2; ++sl) vf[dh][kh][sl] = *(const bf16x8*)(vbp + (size_t)(t * 8 + dh * 4 + kh * 2 + sl) * 1024 + l16);
        f32x16 pA0, pA1, pB0, pB1;
#pragma unroll
        for (int r = 0; r < 16; ++r) { pA0[r] = 0.f; pA1[r] = 0.f; pB0[r] = 0.f; pB1[r] = 0.f; }
        asm volatile("" ::: "memory");
#pragma unroll
        for (int d0 = 0; d0 < 4; ++d0) {
            const bf16x8 qa = qlds[d0 * 64 + lane], qb = qlds[(4 + d0) * 64 + lane];
            pA0 = __builtin_amdgcn_mfma_f32_32x32x16_bf16(kf[0][d0], qa, pA0, 0, 0, 0); pA1 = __builtin_amdgcn_mfma_f32_32x32x16_bf16(kf[1][d0], qa, pA1, 0, 0, 0);
            pB0 = __builtin_amdgcn_mfma_f32_32x32x16_bf16(kf[0][d0], qb, pB0, 0, 0, 0); pB1 = __builtin_amdgcn_mfma_f32_32x32x16_bf16(kf[1][d0], qb, pB1, 0, 0, 0);
        }
        { const int tn = s < 8 ? (s + 1 + rot) % 9 : t;
          __builtin_amdgcn_sched_barrier(0);
#pragma unroll
          for (int kh = 0; kh < 2; ++kh)
#pragma unroll
              for (int d0 = 0; d0 < 4; ++d0) kf[kh][d0] = *(const bf16x8*)(kbp + (size_t)((tn * 2 + kh) * 4 + d0) * 1024 + l16);
          __builtin_amdgcn_sched_barrier(0); }
        attn_half(pA0, pA1, oA0, oA1, mhatA, lA, vf, s == t0, t, r32, hi, r32, wscr, wb);
        __builtin_amdgcn_sched_barrier(0);
        attn_half(pB0, pB1, oB0, oB1, mhatB, lB, vf, s == t0, t, 32 + r32, hi, r32, wscr, wb);
        __builtin_amdgcn_sched_barrier(0);
    }
    char* obp = (char*)(O + row0 * D + 64 * h);
    attn_store_half(oA0, oA1, lA, obp, hi, r32, wscr);
    attn_store_half(oB0, oB1, lB, obp + (size_t)32 * D * 2, hi, r32, wscr);
}

constexpr int NWAVES = 8;
constexpr size_t MiB = 1u << 20;
constexpr size_t WS_SP8 = 512 * 1024;
constexpr size_t WS_SSQ = 1 * MiB, WS_SA = 3 * MiB, WS_SB = 3 * MiB + 512 * 1024;
constexpr size_t WS_WIN = 4 * MiB, WS_WOUT = 8 * MiB, WS_WK = 10 * MiB, WS_WV = 12 * MiB, WS_WQ = 14 * MiB, WS_WO = 16 * MiB, WS_WUP0 = 18 * MiB, WS_WUP1 = 26 * MiB, WS_WDN0 = 34 * MiB, WS_WDN1 = 42 * MiB, WS_WG = 50 * MiB;
constexpr size_t WS_XB = 64 * MiB, WS_BIG = 128 * MiB;
constexpr size_t WS_GATE = WS_BIG, WS_RECPRE = WS_BIG + 64 * MiB, WS_REC = WS_BIG + 128 * MiB, WS_Y = WS_RECPRE;
constexpr size_t WS_K = WS_BIG, WS_VT = WS_BIG + 64 * MiB, WS_Q = WS_BIG + 128 * MiB, WS_O = WS_BIG + 192 * MiB, WS_FF = WS_BIG;
constexpr size_t WS_END = WS_BIG + 256 * MiB;
constexpr int RING_BYTES = 131072, XL_OFF = RING_BYTES, WSCR_OFF = XL_OFF + 2048 + 4096 + 4096, MISC_OFF = WSCR_OFF + NWAVES * 1280, LDS_BYTES = 152576;
static_assert(MISC_OFF + 64 <= LDS_BYTES, "LDS map");
constexpr int N_PHASES = 13;

__device__ __forceinline__ float wave_sum(float v) {
#pragma unroll
    for (int o = 1; o < 64; o <<= 1) v += __shfl_xor(v, o);
    return v;
}
__device__ __forceinline__ unsigned f2bf(float f) { unsigned u = __float_as_uint(f); return (u + 0x7fffu + ((u >> 16) & 1u)) >> 16; }
__device__ __forceinline__ unsigned pk2(float lo, float hi) { return f2bf(lo) | (f2bf(hi) << 16); }

__device__ __forceinline__ void transpose_item(const float* W, int ldw, int col0, int K, int N, const float* gain, bf16_t* WT, int headperm, LAS float* scr, int item, int lane) {
    const int nblk = N / 32, kb = item / nblk, nb = item % nblk, k0 = 64 * kb, n0 = 32 * nb;
    float wv[32];
#pragma unroll
    for (int i = 0; i < 32; ++i) { const int kk = 2 * i + (lane >> 5); wv[i] = W[(size_t)(k0 + kk) * ldw + col0 + n0 + (lane & 31)]; }
#pragma unroll
    for (int i = 0; i < 32; ++i) { const int kk = 2 * i + (lane >> 5); const float gv = gain ? gain[k0 + kk] : 1.f; scr[kk * 33 + (lane & 31)] = wv[i] * gv; }
    asm volatile("s_waitcnt lgkmcnt(0)" ::: "memory");
    const int n0o = headperm ? (256 * (n0 >> 8) + 128 * ((n0 >> 5) & 1) + 32 * ((n0 >> 6) & 3)) : n0;
    const int c = lane & 7;
#pragma unroll
    for (int j = 0; j < 4; ++j) { const int n = (lane >> 3) + 8 * j; const LAS float* s = scr + (8 * c) * 33 + n;
        u32x4 o; o.x = pk2(s[0 * 33], s[1 * 33]); o.y = pk2(s[2 * 33], s[3 * 33]); o.z = pk2(s[4 * 33], s[5 * 33]); o.w = pk2(s[6 * 33], s[7 * 33]);
        *(u32x4*)(WT + (size_t)(n0o + n) * K + k0 + 8 * c) = o; }
    asm volatile("s_waitcnt lgkmcnt(0)" ::: "memory");
}

#define XB_TMO      128
#define XB_XCNT(j)  (256  + 64 * (j))
#define XB_XSUB(j)  (1280 + 64 * (j))
#define XB_XGEN(j)  (2304 + 64 * (j))
#define XB_TOP      3328
#define XB_TOPGEN   3392
#define XCD_BAR_WORDS 3456
#define XB_SPIN_CAP (1u << 22)
__device__ __forceinline__ unsigned xb_ld(unsigned* p)              { return __hip_atomic_load(p, __ATOMIC_RELAXED, __HIP_MEMORY_SCOPE_AGENT); }
__device__ __forceinline__ unsigned xb_add(unsigned* p, unsigned v) { return __hip_atomic_fetch_add(p, v, __ATOMIC_RELAXED, __HIP_MEMORY_SCOPE_AGENT); }
__device__ __forceinline__ unsigned xb_xcc_id() { return (unsigned)__builtin_amdgcn_s_getreg((3 << 11) | 20) & 0xFu; }
#define XB_SPIN(cond, bar) do { unsigned _sp = 0; while (cond) { __builtin_amdgcn_s_sleep(1); \
    if ((++_sp & 255u) == 0u) { if (xb_ld(&(bar)[XB_TMO])) break; if (_sp > XB_SPIN_CAP) { atomicAdd(&(bar)[XB_TMO], 1u); break; } } } } while (0)
struct XcdBarrier { unsigned* bar; unsigned x; volatile LAS unsigned* st; };
__device__ __forceinline__ XcdBarrier xcd_barrier_post(unsigned* bar, volatile LAS unsigned* st, const int tid) {
    XcdBarrier b; b.bar = bar; b.x = xb_xcc_id(); b.st = st;
    if (tid == 0) (void)xb_add(&bar[XB_XCNT(b.x)], 1u);
    return b;
}
__device__ __forceinline__ void xcd_barrier_complete(unsigned* bar, unsigned x, unsigned& nloc, unsigned& nx) {
    const unsigned G = gridDim.x * gridDim.y * gridDim.z;
    unsigned sum, cnt, mine, sp = 0u;
    for (;;) {
        sum = 0u; cnt = 0u; mine = 0u;
#pragma unroll
        for (unsigned j = 0; j < 16; ++j) { const unsigned c = xb_ld(&bar[XB_XCNT(j)]); sum += c; cnt += (c > 0u) ? 1u : 0u; mine = (j == x) ? c : mine; }
        if (sum == G) break;
        __builtin_amdgcn_s_sleep(1);
        if ((++sp & 255u) == 0u) { if (xb_ld(&bar[XB_TMO])) break; if (sp > XB_SPIN_CAP) { atomicAdd(&bar[XB_TMO], 1u); break; } }
    }
    nloc = mine > 0u ? mine : 1u; nx = cnt > 0u ? cnt : 1u;
}
__device__ __forceinline__ void xcd_barrier(const XcdBarrier& b, const int tid) {
    asm volatile("s_waitcnt vmcnt(0)" ::: "memory");
    __syncthreads();
    if (tid == 0) {
        unsigned* bar = b.bar;
        __builtin_amdgcn_s_waitcnt(0);
        unsigned nloc = b.st[0], nx = b.st[1];
        if (nloc == 0u) { xcd_barrier_complete(bar, b.x, nloc, nx); b.st[0] = nloc; b.st[1] = nx; }
        const unsigned old = xb_add(&bar[XB_XSUB(b.x)], 1u);
        const unsigned gen = old / nloc;
        if (old + 1u == (gen + 1u) * nloc) {
            __builtin_amdgcn_fence(__ATOMIC_RELEASE, "agent");
            asm volatile("s_waitcnt vmcnt(0)" ::: "memory");
            const unsigned og = xb_add(&bar[XB_TOP], 1u);
            const unsigned tg = og / nx;
            if (og + 1u == (tg + 1u) * nx) xb_add(&bar[XB_TOPGEN], 1u);
            else XB_SPIN(xb_ld(&bar[XB_TOPGEN]) == tg, bar);
            __builtin_amdgcn_fence(__ATOMIC_ACQUIRE, "agent");
            xb_add(&bar[XB_XGEN(b.x)], 1u);
            asm volatile("s_waitcnt vmcnt(0)" ::: "memory");
        } else {
            XB_SPIN(xb_ld(&bar[XB_XGEN(b.x)]) == gen, bar);
            __builtin_amdgcn_fence(__ATOMIC_ACQUIRE, "agent");
            asm volatile("s_waitcnt vmcnt(0)" ::: "memory");
        }
    }
    __syncthreads();
}

struct Args { const float* in[20]; float* out; unsigned char* ws; int ph_lo, ph_hi, coop, pad; };
enum { I_X = 0, I_ANORM, I_WIN, I_CONVW, I_CONVB, I_WGATE, I_BGATE, I_LAM, I_WOUT, I_KVNORM, I_WKV, I_KNORM, I_BNORM, I_WQ, I_QNORM, I_RELB, I_WO, I_MLPNORM, I_WUP, I_WDOWN };

__global__ void __launch_bounds__(NWAVES * 64, 2) yoco_fwd(Args a) {
    extern __shared__ __attribute__((aligned(16))) unsigned char lds_raw[];
    LAS unsigned char* lds = (LAS unsigned char*)lds_raw;
    LAS unsigned char* xl = lds + XL_OFF;
    const int G = gridDim.x, bx = blockIdx.x;
    const int vcu = (G % 8 == 0) ? (bx % 8) * (G / 8) + bx / 8 : bx;
    unsigned char* ws0 = a.ws;
    typedef const Args __attribute__((address_space(4))) * ArgsP;
    ArgsP ap0 = (ArgsP)__builtin_amdgcn_kernarg_segment_ptr();
    cg::grid_group grid = cg::this_grid();
    const int wave0 = __builtin_amdgcn_readfirstlane(threadIdx.x >> 6);
    volatile LAS unsigned* misc = (volatile LAS unsigned*)(lds + MISC_OFF);
    unsigned* ctl = (unsigned*)ws0;
    if (threadIdx.x < 2) misc[threadIdx.x] = 0u;
    if (a.coop && bx == 0) { for (int i = threadIdx.x; i < XCD_BAR_WORDS; i += NWAVES * 64) ctl[i] = 0u; }
    __syncthreads();
    XcdBarrier bar; bar.bar = ctl; bar.x = 0; bar.st = misc;
    if (a.coop) { grid.sync();
        bar = xcd_barrier_post(ctl, misc, (int)threadIdx.x); }

    for (int pi = a.ph_lo; pi < a.ph_hi + PROBE_REP_N; ++pi) {
        const int ph = (pi <= PROBE_REP_PH) ? pi : (pi - PROBE_REP_N < PROBE_REP_PH ? PROBE_REP_PH : pi - PROBE_REP_N);
            ArgsP ap = ap0; asm volatile("" : "+s"(ap));
        unsigned char* ws = ap->ws;
        float* ssq = (float*)(ws + WS_SSQ); float* SA = (float*)(ws + WS_SA); float* SB = (float*)(ws + WS_SB);
        bf16_t* Win_t = (bf16_t*)(ws + WS_WIN); bf16_t* Wout_t = (bf16_t*)(ws + WS_WOUT); bf16_t* Wk_t = (bf16_t*)(ws + WS_WK); bf16_t* Wv_t = (bf16_t*)(ws + WS_WV);
        bf16_t* Wq_t = (bf16_t*)(ws + WS_WQ); bf16_t* Wo_t = (bf16_t*)(ws + WS_WO); bf16_t* Wg_t = (bf16_t*)(ws + WS_WG);
        bf16_t* XB = (bf16_t*)(ws + WS_XB); bf16_t* GATE = (bf16_t*)(ws + WS_GATE); bf16_t* RECPRE = (bf16_t*)(ws + WS_RECPRE); bf16_t* REC = (bf16_t*)(ws + WS_REC); bf16_t* Y = (bf16_t*)(ws + WS_Y);
        bf16_t* KB = (bf16_t*)(ws + WS_K); bf16_t* VT = (bf16_t*)(ws + WS_VT); bf16_t* QO = (bf16_t*)(ws + WS_Q); bf16_t* OB = (bf16_t*)(ws + WS_O); bf16_t* FFB = (bf16_t*)(ws + WS_FF);
        int tid; asm volatile("v_mbcnt_lo_u32_b32 %0, -1, 0\n\tv_mbcnt_hi_u32_b32 %0, -1, %0" : "=v"(tid)); tid += wave0 * 64; asm volatile("" : "+v"(tid));
        const int lane = tid & 63, wave = __builtin_amdgcn_readfirstlane(tid >> 6);
        if (pi > a.ph_lo && a.coop) xcd_barrier(bar, tid);
        if (pi == 2 && a.coop) { for (int xs = 0; xs < PROBE_XSYNC; ++xs) xcd_barrier(bar, tid); }
        if (ph == 0) {
            LAS float* scr = (LAS float*)(lds + wave * 16384);
            const int gw = vcu * NWAVES + wave, NGW = G * NWAVES;
            constexpr int I_in = 16 * 64, I_sq = 16 * 32, I_up = 16 * 128, I_dn = 64 * 32, I_g = 8 * 16;
            constexpr int NITEMS = I_in + 5 * I_sq + 2 * I_up + 2 * I_dn + I_g;
            for (int it = gw; it < NITEMS; it += NGW) {
                int r = it;
                if (r < I_in) { transpose_item(ap->in[I_WIN], 2 * D, 0, D, 2 * D, ap->in[I_ANORM], Win_t, 0, scr, r, lane); continue; } r -= I_in;
                if (r < I_sq) { transpose_item(ap->in[I_WOUT], D, 0, D, D, nullptr, Wout_t, 0, scr, r, lane); continue; } r -= I_sq;
                if (r < I_sq) { transpose_item(ap->in[I_WKV], 2 * D, 0, D, D, ap->in[I_KVNORM], Wk_t, 1, scr, r, lane); continue; } r -= I_sq;
                if (r < I_sq) { transpose_item(ap->in[I_WKV], 2 * D, D, D, D, ap->in[I_KVNORM], Wv_t, 0, scr, r, lane); continue; } r -= I_sq;
                if (r < I_sq) { transpose_item(ap->in[I_WQ], D, 0, D, D, ap->in[I_BNORM], Wq_t, 1, scr, r, lane); continue; } r -= I_sq;
                if (r < I_sq) { transpose_item(ap->in[I_WO], D, 0, D, D, nullptr, Wo_t, 0, scr, r, lane); continue; } r -= I_sq;
                if (r < 2 * I_up) { const int l = r / I_up; transpose_item(ap->in[I_WUP] + (size_t)l * D * FF, FF, 0, D, FF, ap->in[I_MLPNORM] + l * D, (bf16_t*)(ws + (l ? WS_WUP1 : WS_WUP0)), 0, scr, r % I_up, lane); continue; } r -= 2 * I_up;
                if (r < 2 * I_dn) { const int l = r / I_dn; transpose_item(ap->in[I_WDOWN] + (size_t)l * FF * D, D, 0, FF, D, nullptr, (bf16_t*)(ws + (l ? WS_WDN1 : WS_WDN0)), 0, scr, r % I_dn, lane); continue; } r -= 2 * I_dn;
                { const int blk = r / 16; transpose_item(ap->in[I_WGATE] + (size_t)blk * 128 * 256, 256, 0, 128, 256, nullptr, Wg_t + (size_t)blk * 256 * 128, 0, scr, r % 16, lane); }
            }
            { const float* lam = ap->in[I_LAM]; float* sp8 = (float*)(ws + WS_SP8);
              for (int c = bx * NWAVES * 64 + tid; c < D; c += G * NWAVES * 64) sp8[c] = 8.0f * LOG2E * log1pf(__expf(-lam[c])); }
            const float* x = ap->in[I_X];
            for (int m0 = 4 * gw; m0 < MTOK; m0 += 4 * NGW) {
                f32x4 v[4][4];
#pragma unroll
                for (int rr = 0; rr < 4; ++rr) { const f32x4* xr = (const f32x4*)(x + (size_t)(m0 + rr) * D) + lane;
#pragma unroll
                    for (int j = 0; j < 4; ++j) v[rr][j] = xr[64 * j]; }
#pragma unroll
                for (int rr = 0; rr < 4; ++rr) {
                    float s = 0.f;
#pragma unroll
                    for (int j = 0; j < 4; ++j) s += (v[rr][j][0] * v[rr][j][0] + v[rr][j][1] * v[rr][j][1]) + (v[rr][j][2] * v[rr][j][2] + v[rr][j][3] * v[rr][j][3]);
                    s = wave_sum(s);
                    u32x2* o8 = (u32x2*)(XB + (size_t)(m0 + rr) * D) + lane;
#pragma unroll
                    for (int j = 0; j < 4; ++j) { u32x2 w; w.x = cvt_pk_bf16(v[rr][j][0], v[rr][j][1]); w.y = cvt_pk_bf16(v[rr][j][2], v[rr][j][3]); o8[64 * j] = w; }
                    if (lane < 16) ssq[(size_t)(m0 + rr) * 16 + lane] = (lane == 0) ? s : 0.f;
                }
            }
            __syncthreads();
        }
        else if (ph == 1) {
            pg8::Gemm g{XB, Win_t, MTOK, 2 * D, D, D, D, 0}; pg8::StaticOrder S; S.init(MTOK, 2 * D, G, bx);
            pg8::EpiRowBf16<0> E{ssq, GATE, RECPRE, D};
            pg8::gemm_phase(lds, xl, g, S, E, tid);
        }
        else if (ph == 2) {
            const float* cw = ap->in[I_CONVW]; const float* cb = ap->in[I_CONVB];
            const long nth = (long)G * NWAVES * 64;
            for (long it = (long)bx * NWAVES * 64 + tid; it < (long)(MTOK / 8) * 128; it += nth) {
                const long row0 = (it >> 7) * 8; const int c = (int)(it & 127) * 8; const int s0 = (int)(row0 & (SEQ - 1));
                u32x4 xin[11];
#pragma unroll
                for (int i = 0; i < 11; ++i) { if (i >= 3 || s0 > 0) xin[i] = *(const u32x4*)(RECPRE + (size_t)(row0 - 3 + i) * D + c); else xin[i] = (u32x4){0u, 0u, 0u, 0u}; }
                f32x4 w0[4], w1[4];
#pragma unroll
                for (int k = 0; k < 4; ++k) { w0[k] = *(const f32x4*)(cw + k * D + c); w1[k] = *(const f32x4*)(cw + k * D + c + 4); }
                const f32x4 b0 = *(const f32x4*)(cb + c), b1 = *(const f32x4*)(cb + c + 4);
#pragma unroll
                for (int o = 0; o < 8; ++o) {
                    f32x4 a0 = b0, a1 = b1;
#pragma unroll
                    for (int k = 0; k < 4; ++k) { const u32x4 r = xin[o + k];
                        a0 += w0[k] * (f32x4){bf_lo(r.x), bf_hi(r.x), bf_lo(r.y), bf_hi(r.y)}; a1 += w1[k] * (f32x4){bf_lo(r.z), bf_hi(r.z), bf_lo(r.w), bf_hi(r.w)}; }
                    u32x4 ov; ov.x = cvt_pk_bf16(a0[0], a0[1]); ov.y = cvt_pk_bf16(a0[2], a0[3]); ov.z = cvt_pk_bf16(a1[0], a1[1]); ov.w = cvt_pk_bf16(a1[2], a1[3]);
                    *(u32x4*)(REC + (size_t)(row0 + o) * D + c) = ov;
                }
            }
        }
        else if (ph == 3 || ph == 4) {
            pg8::Gemm g{REC, Wg_t, MTOK, 8 * 256, 128, D, 128, 128 * 2}; pg8::StaticOrder S; S.init(MTOK, 8 * 256, G, bx);
            pg8::EpiGate E{ssq, (PROBE_REP_N > 0 && PROBE_VARIANT >= 2 && pi == PROBE_REP_PH) ? PROBE_VARIANT : ph - 3, REC, GATE, Y, ap->in[I_BGATE], (const float*)(ws + WS_SP8), SA, SB};
            if (wave >= 4) __builtin_amdgcn_s_setprio(1);
            pg8::gemm_k128_phase(lds, xl, g, S, E, tid);
            __builtin_amdgcn_s_setprio(0);
        }
        else if (ph == 5 || ph == 7 || ph == 10 || ph == 12) {
            const bf16_t* A = (ph == 5) ? Y : (ph == 10) ? OB : FFB;
            const bf16_t* Bt = (ph == 5) ? Wout_t : (ph == 10) ? Wo_t : (bf16_t*)(ws + (ph == 7 ? WS_WDN0 : WS_WDN1));
            const int K = (ph == 5 || ph == 10) ? D : FF;
            pg8::Gemm g{A, Bt, MTOK, D, K, K, K, 0}; pg8::StaticOrder S; S.init(MTOK, D, G, bx);
            pg8::EpiResid E{ssq, ap->out, XB, ssq, (ph == 12 || (PROBE_REP_N > 0 && pi == PROBE_REP_PH)) ? 1 : 0};
            pg8::gemm_phase(lds, xl, g, S, E, tid);
        }
        else if (ph == 6 || ph == 11) {
            pg8::Gemm g{XB, (bf16_t*)(ws + (ph == 6 ? WS_WUP0 : WS_WUP1)), MTOK, FF, D, D, D, 0}; pg8::StaticOrder S; S.init(MTOK, FF, G, bx, 4);
            pg8::EpiRowBf16<1> E{ssq, FFB, FFB, FF};
            pg8::gemm_phase(lds, xl, g, S, E, tid);
        }
        else if (ph == 8) {
            { pg8::Gemm g{Wv_t, XB, D, MTOK, D, D, D, 0}; pg8::StaticOrder S; S.init(D, MTOK, G, bx);
              pg8::EpiVT E{ssq, VT};
              pg8::gemm_phase(lds, xl, g, S, E, tid); }
            for (int w = 0; w < 2; ++w) {
                pg8::Gemm g{XB, w ? Wq_t : Wk_t, MTOK, D, D, D, D, 0}; pg8::StaticOrder S; S.init(MTOK, D, G, bx);
                if (w) { pg8::EpiHead<false> E{ssq, QO, ap->in[I_QNORM], QSCALE}; pg8::gemm_phase(lds, xl, g, S, E, tid); }
                else { pg8::EpiHead<true> E{ssq, KB, ap->in[I_KNORM], 1.f}; pg8::gemm_phase(lds, xl, g, S, E, tid); }
            }
        }
        else if (ph == 9) {
            LAS float* wscr = (LAS float*)(lds + WSCR_OFF) + wave * 320;
            if (wave >= 4) __builtin_amdgcn_s_setprio(1);
            LAS bf16x8* qlds = (LAS bf16x8*)(lds + wave * 8192);
            const int nit = (BATCH * NH * 256 + G * NWAVES - 1) / (G * NWAVES);
            for (int r = 0; r < nit; ++r) {
                int bh, ch;
                if (G == 256) { bh = (bx & 7) * 4 + r; ch = (bx >> 3) * 8 + wave; }
                else { const int it = r * G * NWAVES + bx * NWAVES + wave; if (it >= BATCH * NH * 256) break; bh = it >> 8; ch = it & 255; }
                attn_unit64(bh >> 4, bh & 15, ch, QO, KB, VT, OB, ap->in[I_RELB], wscr, qlds, lane);
            }
            __builtin_amdgcn_s_setprio(0);
        }
    }
}

extern "C" void kernel_launch(void* const* d_in, const int* in_sizes, int n_in, void* d_out, int out_size, void* d_ws, size_t ws_size, hipStream_t stream) {
    static int grid = 0;
    if (grid == 0) {
        if (n_in != 20 || in_sizes[0] != MTOK * D || out_size != MTOK * D || ws_size < WS_END) { fprintf(stderr, "kernel_launch: unexpected shapes (n_in %d in0 %d out %d ws %zu)\n", n_in, n_in > 0 ? in_sizes[0] : -1, out_size, ws_size); grid = -1; return; }
        int dev = 0, cus = 0, per_cu = 0;
        hipGetDevice(&dev); hipDeviceGetAttribute(&cus, hipDeviceAttributeMultiprocessorCount, dev);
        if (hipFuncSetAttribute((const void*)yoco_fwd, hipFuncAttributeMaxDynamicSharedMemorySize, LDS_BYTES) != hipSuccess) { fprintf(stderr, "kernel_launch: hipFuncSetAttribute failed\n"); grid = -1; return; }
        if (hipOccupancyMaxActiveBlocksPerMultiprocessor(&per_cu, (const void*)yoco_fwd, NWAVES * 64, LDS_BYTES) != hipSuccess || per_cu < 1) { fprintf(stderr, "kernel_launch: occupancy query says %d\n", per_cu); per_cu = 1; }
        (void)hipGetLastError();
        grid = cus;
        if (grid > cus * per_cu) grid = cus * per_cu;
    }
    if (grid < 0) return;
    Args a{};
    for (int i = 0; i < 20; ++i) a.in[i] = (const float*)d_in[i];
    a.out = (float*)d_out; a.ws = (unsigned char*)d_ws;
#if MK_MULTI
    for (int ph = 0; ph < N_PHASES; ++ph) { a.ph_lo = ph; a.ph_hi = ph + 1; a.coop = 0;
        hipLaunchKernelGGL(yoco_fwd, dim3(grid), dim3(NWAVES * 64), LDS_BYTES, stream, a); }
#else
    a.ph_lo = 0; a.ph_hi = N_PHASES; a.coop = 1;
    void* args[] = {&a};
    hipError_t e = hipLaunchCooperativeKernel((const void*)yoco_fwd, dim3(grid), dim3(NWAVES * 64), args, LDS_BYTES, stream);
    if (e != hipSuccess) fprintf(stderr, "kernel_launch: cooperative launch failed: %s (grid %d)\n", hipGetErrorString(e), grid);
#endif
}
```

```cpp
#include <hip/hip_runtime.h>
#include <hip/hip_cooperative_groups.h>
#include <cstdio>
#include <cstdint>
namespace cg = cooperative_groups;

#ifndef PROBE_REP_PH
#define PROBE_REP_PH 0
#define PROBE_REP_N 0
#define PROBE_XSYNC 0
#define PROBE_VARIANT 0
#endif
#ifndef MK_MULTI
#define MK_MULTI 0
#endif

#define LAS __attribute__((address_space(3)))
typedef unsigned short bf16_t;
typedef short bf16x8 __attribute__((ext_vector_type(8)));
typedef float f32x4 __attribute__((ext_vector_type(4)));
typedef float f32x2 __attribute__((ext_vector_type(2)));
typedef float f32x16 __attribute__((ext_vector_type(16)));
typedef unsigned u32x4 __attribute__((ext_vector_type(4)));
typedef unsigned u32x2 __attribute__((ext_vector_type(2)));

constexpr int BATCH = 2, SEQ = 16384, MTOK = BATCH * SEQ, D = 1024, FF = 4096, NH = 16, HD = 64, NREL = 192;
constexpr float EPS = 1e-6f, LOG2E = 1.4426950408889634f;
constexpr float QSCALE = 0.125f * LOG2E;

__device__ __forceinline__ unsigned cvt_pk_bf16(float lo, float hi) { unsigned r; asm volatile("v_cvt_pk_bf16_f32 %0, %1, %2" : "=v"(r) : "v"(lo), "v"(hi)); return r; }
__device__ __forceinline__ float bf_lo(unsigned u) { return __uint_as_float(u << 16); }
__device__ __forceinline__ float bf_hi(unsigned u) { return __uint_as_float(u & 0xffff0000u); }
__device__ __forceinline__ float fast_exp2(float x) { return __builtin_amdgcn_exp2f(x); }
__device__ __forceinline__ float fast_rcp(float x) { return __builtin_amdgcn_rcpf(x); }
__device__ __forceinline__ float sigmoidf_(float x) { return fast_rcp(1.f + fast_exp2(-LOG2E * x)); }
__device__ __forceinline__ float gelu_tanh(float v) { const float u = v * (1.f + 0.044715f * v * v); return v * fast_rcp(1.f + fast_exp2(-LOG2E * 1.5957691216057308f * u)); }

namespace pg8 {
constexpr int BM = 256, BK = 64, HALF = 128, HTB = HALF * BK * 2, STAGE_BYTES = 8 * HTB, NXCD = 8, WGM = 8;
__host__ __device__ __forceinline__ int lds_byte(int r, int c) { const int st = (r >> 4) * 2 + (c >> 5), rr = r & 15, cc = c & 31, ob = rr * 64 + cc * 2; return st * 1024 + (ob ^ (((ob >> 9) & 1) << 5)); }
__host__ __device__ __forceinline__ void stage_rc(int b, int& R, int& C) { const int st = b / 1024, sb = b % 1024, swz = sb ^ (((sb >> 9) & 1) << 5); R = (st >> 1) * 16 + swz / 64; C = (st & 1) * 32 + (swz % 64) / 2; }
__host__ __device__ __forceinline__ int perm32(int rho) { const int n = rho >> 4, i = rho & 15; return 8 * (i >> 2) + 4 * n + (i & 3); }

__device__ __forceinline__ void glds16_s(const void* sbase, unsigned voff, unsigned lds_dst) {
    unsigned keep;
    asm volatile("s_mov_b32 %0, m0\n\ts_mov_b32 m0, %3\n\ts_nop 0\n\tglobal_load_lds_dwordx4 %1, %2\n\ts_mov_b32 m0, %0"
                 : "=&s"(keep) : "v"(voff), "s"(sbase), "s"(lds_dst) : "memory");
}
struct Unit { int pm, pn; };
struct Gemm { const bf16_t* A; const bf16_t* Bt; int M, N, K, lda, ldb; long a_pn_off; };

struct StaticOrder {
    int nM, nN, nwg, G, c, wgm;
    __device__ void init(int M, int N, int G_, int c_, int wgm_ = WGM) { nM = M / BM; nN = N / BM; nwg = nM * nN; G = G_; c = c_; wgm = wgm_; }
    __device__ bool next(int i, Unit& u) const {
        const long L = (long)i * G + c; if (L >= nwg) return false;
        int wgid = (int)L; { const int q = nwg / NXCD, r = nwg % NXCD, xcd = wgid % NXCD, off = wgid / NXCD; wgid = (xcd < r ? xcd * (q + 1) : r * (q + 1) + (xcd - r) * q) + off; }
        const int nig = wgm * nN, gid = wgid / nig, fm = gid * wgm, gsz = (nM - fm) < wgm ? (nM - fm) : wgm;
        u.pm = fm + ((wgid % nig) % gsz); u.pn = (wgid % nig) / gsz; return true;
    }
};

typedef f32x4 Acc[2][2][4][2];
typedef f32x4 AccH[2][4][2];

template <class Epi>
__device__ __forceinline__ void rs_prep(const Epi& E, const Unit& u, int parity, LAS float* rsbuf, int tid) {
    if constexpr (Epi::RS_MODE != 0) {
        if (tid < 256) {
            asm volatile("" : "+v"(tid));
            const int row = (Epi::RS_MODE == 1 ? u.pm : u.pn) * 256 + tid;
            const f32x4* p = (const f32x4*)(E.ssq + (size_t)row * 16);
            const f32x4 a = p[0], b = p[1], c = p[2], d = p[3];
            const float s = ((a[0] + a[1]) + (a[2] + a[3])) + ((b[0] + b[1]) + (b[2] + b[3])) + ((c[0] + c[1]) + (c[2] + c[3])) + ((d[0] + d[1]) + (d[2] + d[3]));
            rsbuf[parity * 256 + tid] = __builtin_amdgcn_rsqf(s * (1.f / 1024.f) + EPS);
        }
    }
}

template <class Epi>
__device__ __forceinline__ void gemm_phase(LAS unsigned char* lds, LAS unsigned char* xl, const Gemm g, const StaticOrder& S, const Epi& E, const int tid) {
    const int wid = __builtin_amdgcn_readfirstlane(tid >> 6), lane = tid & 63, wr = wid >> 2, wc = wid & 3, fr = lane & 15, fq = lane >> 4;
    const int K = g.K, nt = K / BK;
    unsigned voffA[2], voffB[2];
#pragma unroll
    for (int i = 0; i < 2; ++i) { int R, C; stage_rc(tid * 16 + i * 8192, R, C); const int Rb = Epi::PERM ? ((R & ~31) + perm32(R & 31)) : R;
        voffA[i] = (unsigned)(R * g.lda + C) * 2u; voffB[i] = (unsigned)(Rb * g.ldb + C) * 2u; }
    const size_t kstep = (size_t)(BK * 2);
    const size_t hstepA = (size_t)HALF * g.lda * 2, hstepB = (size_t)HALF * g.ldb * 2, tstepA = 2 * hstepA, tstepB = 2 * hstepB;
    const unsigned ldsw = (unsigned)wid * 1024u, lds0 = (unsigned)(size_t)lds;
    const int aoff = lds_byte(wr * 64 + fr, fq * 8), boff = lds_byte(wc * 32 + fr, fq * 8);
    LAS float* rsbuf = (LAS float*)xl;
#define PG8_SA(b, h) (((b) * 2 + (h)) * HTB)
#define PG8_SB(b, h) ((4 + (b) * 2 + (h)) * HTB)
#define PG8_STAGE(bufoff, gbase, voff) do { _Pragma("unroll") for (int _i = 0; _i < 2; ++_i) \
        glds16_s((const void*)(gbase), (voff)[_i], (unsigned)__builtin_amdgcn_readfirstlane((int)(lds0 + (unsigned)(bufoff) + ldsw + _i * 8192))); } while (0)
#define PG8_LDA(dst, b, h) do { _Pragma("unroll") for (int m = 0; m < 4; ++m) _Pragma("unroll") for (int k = 0; k < 2; ++k) dst[m][k] = *(const LAS bf16x8*)(lds + PG8_SA(b, h) + aoff + m * 2048 + k * 1024); } while (0)
#define PG8_LDB(dst, b, h) do { _Pragma("unroll") for (int n = 0; n < 2; ++n) _Pragma("unroll") for (int k = 0; k < 2; ++k) dst[n][k] = *(const LAS bf16x8*)(lds + PG8_SB(b, h) + boff + n * 2048 + k * 1024); } while (0)
#define PG8_MMA(ai, bj, At, Bt) do { __builtin_amdgcn_s_setprio(1); _Pragma("unroll") for (int m = 0; m < 4; ++m) _Pragma("unroll") for (int n = 0; n < 2; ++n) _Pragma("unroll") for (int k = 0; k < 2; ++k) \
        acc[ai][bj][m][n] = __builtin_amdgcn_mfma_f32_16x16x32_bf16(Bt[n][k], At[m][k], acc[ai][bj][m][n], 0, 0, 0); __builtin_amdgcn_s_setprio(0); } while (0)
#define PG8_WAIT_V(n) asm volatile("s_waitcnt vmcnt(" #n ")" ::: "memory")
#define PG8_WAIT_L(n) asm volatile("s_waitcnt lgkmcnt(" #n ")" ::: "memory")
#define PG8_BAR __builtin_amdgcn_s_barrier()
#define PG8_SCHED __builtin_amdgcn_sched_barrier(0)
    Unit cur, nxt; int ui = 0;
    if (!S.next(0, cur)) return;
    rs_prep(E, cur, 0, rsbuf, tid);
    const char* cA = (const char*)g.A + (size_t)cur.pm * tstepA + (size_t)cur.pn * g.a_pn_off; const char* cB = (const char*)g.Bt + (size_t)cur.pn * tstepB;
    PG8_SCHED; PG8_STAGE(PG8_SB(0, 0), cB, voffB); PG8_SCHED; PG8_STAGE(PG8_SB(0, 1), cB + hstepB, voffB); PG8_SCHED; PG8_STAGE(PG8_SA(0, 0), cA, voffA); PG8_SCHED; PG8_STAGE(PG8_SA(0, 1), cA + hstepA, voffA); PG8_SCHED;
    if (wr == 1) PG8_BAR;
    PG8_WAIT_V(2); PG8_BAR;
    PG8_SCHED; PG8_STAGE(PG8_SB(1, 0), cB + kstep, voffB); PG8_SCHED; PG8_STAGE(PG8_SA(1, 0), cA + kstep, voffA); PG8_SCHED; PG8_STAGE(PG8_SB(1, 1), cB + hstepB + kstep, voffB); PG8_SCHED;
    PG8_WAIT_V(6); PG8_BAR;
    PG8_SCHED;
    Acc acc;
#pragma unroll
    for (int a = 0; a < 2; ++a)
#pragma unroll
        for (int b = 0; b < 2; ++b)
#pragma unroll
            for (int m = 0; m < 4; ++m)
#pragma unroll
                for (int n = 0; n < 2; ++n) acc[a][b][m][n] = (f32x4){0.f, 0.f, 0.f, 0.f};
    bf16x8 At[4][2], B0[2][2], B1[2][2];
    for (;;) {
        const bool has_next = S.next(ui + 1, nxt);
        const char* nA = has_next ? (const char*)g.A + (size_t)nxt.pm * tstepA + (size_t)nxt.pn * g.a_pn_off : cA; const char* nB = has_next ? (const char*)g.Bt + (size_t)nxt.pn * tstepB : cB;
        for (int t = 0; t < nt; t += 2) {
            const bool last = (t == nt - 2);
            const char* a1 = cA + (size_t)(t + 1) * kstep;
            const char* a2 = last ? nA : cA + (size_t)(t + 2) * kstep; const char* b2 = last ? nB : cB + (size_t)(t + 2) * kstep;
            const char* a3 = a2 + kstep; const char* b3 = b2 + kstep;
            PG8_LDB(B0, 0, 0); PG8_LDB(B1, 0, 1); PG8_SCHED; PG8_LDA(At, 0, 0); PG8_STAGE(PG8_SA(1, 1), a1 + hstepA, voffA);
            PG8_WAIT_V(8); PG8_WAIT_L(0); PG8_BAR; PG8_MMA(0, 0, At, B0); PG8_MMA(0, 1, At, B1); PG8_BAR; PG8_SCHED;
            PG8_LDA(At, 0, 1); PG8_STAGE(PG8_SB(0, 0), b2, voffB); PG8_STAGE(PG8_SB(0, 1), b2 + hstepB, voffB); PG8_STAGE(PG8_SA(0, 0), a2, voffA);
            PG8_WAIT_V(8); PG8_WAIT_L(0); PG8_BAR; PG8_MMA(1, 0, At, B0); PG8_MMA(1, 1, At, B1); PG8_BAR; PG8_SCHED;
            PG8_LDB(B0, 1, 0); PG8_LDB(B1, 1, 1); PG8_SCHED; PG8_LDA(At, 1, 0); PG8_STAGE(PG8_SA(0, 1), a2 + hstepA, voffA);
            PG8_WAIT_V(8); PG8_WAIT_L(0); PG8_BAR; PG8_MMA(0, 0, At, B0); PG8_MMA(0, 1, At, B1); PG8_BAR; PG8_SCHED;
            PG8_LDA(At, 1, 1); PG8_STAGE(PG8_SB(1, 0), b3, voffB); PG8_STAGE(PG8_SB(1, 1), b3 + hstepB, voffB); PG8_STAGE(PG8_SA(1, 0), a3, voffA);
            PG8_WAIT_V(8); PG8_WAIT_L(0); PG8_BAR; PG8_MMA(1, 0, At, B0); PG8_MMA(1, 1, At, B1); PG8_BAR; PG8_SCHED;
        }
        if (wr == 0) PG8_BAR;
        E(acc, cur, wr, wc, fr, fq, xl, rsbuf + (ui & 1) * 256, tid);
        if (!has_next) break;
        rs_prep(E, nxt, (ui + 1) & 1, rsbuf, tid);
#pragma unroll
        for (int a = 0; a < 2; ++a)
#pragma unroll
            for (int b = 0; b < 2; ++b)
#pragma unroll
                for (int m = 0; m < 4; ++m)
#pragma unroll
                    for (int n = 0; n < 2; ++n) acc[a][b][m][n] = (f32x4){0.f, 0.f, 0.f, 0.f};
        cur = nxt; cA = nA; cB = nB; ++ui;
        if (wr == 1) PG8_BAR;
    }
    PG8_WAIT_V(0);
    PG8_BAR;
}

template <class Epi>
__device__ __forceinline__ void gemm_k128_phase(LAS unsigned char* lds, LAS unsigned char* xl, const Gemm g, const StaticOrder& S, const Epi& E, const int tid) {
    const int wid = __builtin_amdgcn_readfirstlane(tid >> 6), lane = tid & 63, wr = wid >> 2, wc = wid & 3, fr = lane & 15, fq = lane >> 4;
    const size_t kstep = (size_t)(BK * 2);
    const size_t hstepA = (size_t)HALF * g.lda * 2, hstepB = (size_t)HALF * g.ldb * 2, tstepA = 2 * hstepA, tstepB = 2 * hstepB;
    const unsigned ldsw = (unsigned)wid * 1024u, lds0 = (unsigned)(size_t)lds;
    const int aoff = lds_byte(wr * 64 + fr, fq * 8), boff = lds_byte(wc * 32 + fr, fq * 8);
#define PG8_STAGE_ALL(uu) do { int t_ = tid; asm volatile("" : "+v"(t_)); unsigned vA[2], vB[2]; \
        _Pragma("unroll") for (int i = 0; i < 2; ++i) { int R, C; stage_rc(t_ * 16 + i * 8192, R, C); const int Rb = Epi::PERM ? ((R & ~31) + perm32(R & 31)) : R; const int Ra = (R & 64) | (4 * (R & 15) + ((R >> 4) & 3));     \
            vA[i] = (unsigned)(Ra * g.lda + C) * 2u; vB[i] = (unsigned)(Rb * g.ldb + C) * 2u; } \
        const char* pA = (const char*)g.A + (size_t)(uu).pm * tstepA + (size_t)(uu).pn * g.a_pn_off; const char* pB = (const char*)g.Bt + (size_t)(uu).pn * tstepB; \
        _Pragma("unroll") for (int b = 0; b < 2; ++b) _Pragma("unroll") for (int h = 0; h < 2; ++h) { PG8_STAGE(PG8_SA(b, h), pA + h * hstepA + b * kstep, vA); PG8_STAGE(PG8_SB(b, h), pB + h * hstepB + b * kstep, vB); } } while (0)
#define PG8_MMAH(bj, At, Bt) do { _Pragma("unroll") for (int m = 0; m < 4; ++m) _Pragma("unroll") for (int n = 0; n < 2; ++n) _Pragma("unroll") for (int k = 0; k < 2; ++k) \
        acc[bj][m][n] = __builtin_amdgcn_mfma_f32_16x16x32_bf16(Bt[n][k], At[m][k], acc[bj][m][n], 0, 0, 0); } while (0)
    Unit cur, nxt;
    if (!S.next(0, cur)) return;
    PG8_STAGE_ALL(cur);
    for (int ui = 0;; ++ui) {
        PG8_WAIT_V(0); PG8_BAR;
        const bool has_next = S.next(ui + 1, nxt);
#pragma unroll
        for (int ai = 0; ai < 2; ++ai) {
            AccH acc;
#pragma unroll
            for (int b = 0; b < 2; ++b)
#pragma unroll
                for (int m = 0; m < 4; ++m)
#pragma unroll
                    for (int n = 0; n < 2; ++n) acc[b][m][n] = (f32x4){0.f, 0.f, 0.f, 0.f};
            { bf16x8 At[4][2], B0[2][2], B1[2][2];
              PG8_LDB(B0, 0, 0); PG8_LDB(B1, 0, 1); PG8_LDA(At, 0, ai); PG8_WAIT_L(0); PG8_MMAH(0, At, B0); PG8_MMAH(1, At, B1);
              PG8_LDB(B0, 1, 0); PG8_LDB(B1, 1, 1); PG8_LDA(At, 1, ai); PG8_WAIT_L(0); PG8_MMAH(0, At, B0); PG8_MMAH(1, At, B1); }
            if (ai == 1) { PG8_BAR;
                if (has_next) PG8_STAGE_ALL(nxt); }
            PG8_SCHED;
            E.half(acc, cur, ai, wr, wc, fr, fq, xl, tid);
            PG8_SCHED;
        }
        if (!has_next) break;
        cur = nxt;
    }
    PG8_WAIT_V(0);
    PG8_BAR;
#undef PG8_MMAH
#undef PG8_STAGE_ALL
#undef PG8_SA
#undef PG8_SB
#undef PG8_STAGE
#undef PG8_LDA
#undef PG8_LDB
#undef PG8_MMA
#undef PG8_WAIT_V
#undef PG8_WAIT_L
#undef PG8_BAR
#undef PG8_SCHED
}

template <int MODE> struct EpiRowBf16 {
    static constexpr bool PERM = true; static constexpr int RS_MODE = 1;
    const float* ssq; bf16_t* O0; bf16_t* O1; int ldc;
    __device__ __forceinline__ void operator()(Acc& acc, const Unit& u, int wr, int wc, int fr, int fq, LAS unsigned char* xl, const LAS float* rs, int tid) const {
        asm volatile("" : "+v"(fr), "+v"(fq), "+v"(tid));
        bf16_t* base; int colt = u.pn * BM;
        if (MODE == 0) { if (colt >= D) { base = O1; colt -= D; } else base = O0; } else base = O0;
        const bool act_gelu = (MODE == 0) && (u.pn * BM < D);
        const int col0 = colt + wc * 32 + 8 * fq;
#pragma unroll
        for (int ai = 0; ai < 2; ++ai)
#pragma unroll
            for (int m = 0; m < 4; ++m) {
                const int rl = ai * HALF + wr * 64 + m * 16 + fr; const float r = rs[rl];
                bf16_t* rowp = base + (size_t)(u.pm * BM + rl) * ldc + col0;
#pragma unroll
                for (int bj = 0; bj < 2; ++bj) {
                    f32x4 v0 = acc[ai][bj][m][0] * r, v1 = acc[ai][bj][m][1] * r;
                    if (MODE == 0) { if (act_gelu) {
#pragma unroll
                        for (int j = 0; j < 4; ++j) { v0[j] = gelu_tanh(v0[j]); v1[j] = gelu_tanh(v1[j]); } } }
                    else {
#pragma unroll
                        for (int j = 0; j < 4; ++j) { const float a = fmaxf(v0[j], 0.f), b = fmaxf(v1[j], 0.f); v0[j] = a * a; v1[j] = b * b; } }
                    u32x4 w; w.x = cvt_pk_bf16(v0[0], v0[1]); w.y = cvt_pk_bf16(v0[2], v0[3]); w.z = cvt_pk_bf16(v1[0], v1[1]); w.w = cvt_pk_bf16(v1[2], v1[3]);
                    *(u32x4*)(rowp + bj * HALF) = w; }
                asm volatile("" ::: "memory"); __builtin_amdgcn_sched_barrier(0);
            }
    }
};
template <bool KP> struct EpiHead {
    static constexpr bool PERM = true; static constexpr int RS_MODE = 1;
    const float* ssq; bf16_t* O; const float* gain; float scale;
    __device__ __forceinline__ void operator()(Acc& acc, const Unit& u, int wr, int wc, int fr, int fq, LAS unsigned char* xl, const LAS float* rs, int tid) const {
        asm volatile("" : "+v"(fr), "+v"(fq), "+v"(tid));
        f32x4 gv[2][2];
#pragma unroll
        for (int bj = 0; bj < 2; ++bj)
#pragma unroll
            for (int n = 0; n < 2; ++n) gv[bj][n] = *(const f32x4*)(gain + 32 * bj + 8 * fq + 4 * n) * scale;
        const int col0 = u.pn * BM + 64 * wc + 8 * fq;
#pragma unroll
        for (int ai = 0; ai < 2; ++ai)
#pragma unroll
            for (int m = 0; m < 4; ++m) {
                const int rl = ai * HALF + wr * 64 + m * 16 + fr; const float r = rs[rl];
                float ss = 0.f;
#pragma unroll
                for (int bj = 0; bj < 2; ++bj)
#pragma unroll
                    for (int n = 0; n < 2; ++n) { acc[ai][bj][m][n] = acc[ai][bj][m][n] * r; const f32x4 x = acc[ai][bj][m][n]; ss += (x[0] * x[0] + x[1] * x[1]) + (x[2] * x[2] + x[3] * x[3]); }
                ss += __shfl_xor(ss, 16); ss += __shfl_xor(ss, 32);
                const float hr = __builtin_amdgcn_rsqf(ss * (1.f / 64.f) + EPS);
                bf16_t* rowp;
                if (KP) { const int row = u.pm * BM + rl, b = row / SEQ, s = row % SEQ, k5 = s & 31, rho = (k5 & 0x13) | ((k5 & 4) << 1) | ((k5 & 8) >> 1);
                    rowp = O + ((size_t)((b * NH + 4 * u.pn + wc) * (SEQ / 32) + (s >> 5)) * 4 * 64 + (size_t)((fq >> 1) * 64 + 32 * (fq & 1) + rho)) * 8; }
                else rowp = O + (size_t)(u.pm * BM + rl) * D + col0;
#pragma unroll
                for (int bj = 0; bj < 2; ++bj) { const f32x4 v0 = acc[ai][bj][m][0] * hr * gv[bj][0], v1 = acc[ai][bj][m][1] * hr * gv[bj][1];
                    u32x4 w; w.x = cvt_pk_bf16(v0[0], v0[1]); w.y = cvt_pk_bf16(v0[2], v0[3]); w.z = cvt_pk_bf16(v1[0], v1[1]); w.w = cvt_pk_bf16(v1[2], v1[3]);
                    *(u32x4*)(rowp + (KP ? 2 * 64 * 8 * bj : 32 * bj)) = w; }
                asm volatile("" ::: "memory"); __builtin_amdgcn_sched_barrier(0);
            }
    }
};
struct EpiVT {
    static constexpr bool PERM = true; static constexpr int RS_MODE = 2;
    const float* ssq; bf16_t* O;
    __device__ __forceinline__ void operator()(Acc& acc, const Unit& u, int wr, int wc, int fr, int fq, LAS unsigned char* xl, const LAS float* rs, int tid) const {
        asm volatile("" : "+v"(fr), "+v"(fq), "+v"(tid));
        f32x4 rv[2][2];
#pragma unroll
        for (int bj = 0; bj < 2; ++bj)
#pragma unroll
            for (int n = 0; n < 2; ++n) rv[bj][n] = *(const LAS f32x4*)(rs + bj * HALF + wc * 32 + 8 * fq + 4 * n);
        const int col0 = u.pn * BM + wc * 32 + 8 * fq;
#pragma unroll
        for (int ai = 0; ai < 2; ++ai)
#pragma unroll
            for (int m = 0; m < 4; ++m) {
                const int f = u.pm * BM + ai * HALF + wr * 64 + m * 16 + fr, hh = f >> 6, dd = f & 63;
#pragma unroll
                for (int bj = 0; bj < 2; ++bj) { const f32x4 v0 = acc[ai][bj][m][0] * rv[bj][0], v1 = acc[ai][bj][m][1] * rv[bj][1];
                    u32x4 w; w.x = cvt_pk_bf16(v0[0], v0[1]); w.y = cvt_pk_bf16(v0[2], v0[3]); w.z = cvt_pk_bf16(v1[0], v1[1]); w.w = cvt_pk_bf16(v1[2], v1[3]);
                    const int t0 = col0 + bj * HALF, b = t0 / SEQ, s = t0 % SEQ;
                    bf16_t* p = O + ((size_t)((b * NH + hh) * (SEQ / 64) + (s >> 6)) * 8 * 64 + (size_t)(((dd >> 5) * 4 + ((s >> 4) & 3)) * 64 + 32 * ((s >> 3) & 1) + (dd & 31))) * 8;
                    *(u32x4*)p = w; }
                asm volatile("" ::: "memory"); __builtin_amdgcn_sched_barrier(0);
            }
    }
};
struct EpiResid {
    static constexpr bool PERM = true; static constexpr int RS_MODE = 0;
    const float* ssq; float* out; bf16_t* hb; float* ssq_out; int last;
    __device__ __forceinline__ void operator()(Acc& acc, const Unit& u, int wr, int wc, int fr, int fq, LAS unsigned char* xl, const LAS float* rs, int tid) const {
        asm volatile("" : "+v"(fr), "+v"(fq), "+v"(tid));
        const int col0 = u.pn * BM + wc * 32 + 8 * fq;
#pragma unroll
        for (int ai = 0; ai < 2; ++ai) {
            float ssm[4];
            u32x4 bsr[4][2];
#pragma unroll
            for (int m = 0; m < 4; ++m)
#pragma unroll
                for (int bj = 0; bj < 2; ++bj) bsr[m][bj] = *(const u32x4*)(hb + (size_t)(u.pm * BM + ai * HALF + wr * 64 + m * 16 + fr) * D + col0 + bj * HALF);
#pragma unroll
            for (int m = 0; m < 4; ++m) {
                const int row = u.pm * BM + ai * HALF + wr * 64 + m * 16 + fr; const size_t off = (size_t)row * D + col0;
                float ss = 0.f;
#pragma unroll
                for (int bj = 0; bj < 2; ++bj) {
                    const u32x4 b = bsr[m][bj];
                    const f32x4 o0 = (f32x4){bf_lo(b.x), bf_hi(b.x), bf_lo(b.y), bf_hi(b.y)} + acc[ai][bj][m][0], o1 = (f32x4){bf_lo(b.z), bf_hi(b.z), bf_lo(b.w), bf_hi(b.w)} + acc[ai][bj][m][1];
                    if (last) { *(f32x4*)(out + off + bj * HALF) = o0; *(f32x4*)(out + off + bj * HALF + 4) = o1; }
                    else { ss += ((o0[0] * o0[0] + o0[1] * o0[1]) + (o0[2] * o0[2] + o0[3] * o0[3])) + ((o1[0] * o1[0] + o1[1] * o1[1]) + (o1[2] * o1[2] + o1[3] * o1[3]));
                        u32x4 w; w.x = cvt_pk_bf16(o0[0], o0[1]); w.y = cvt_pk_bf16(o0[2], o0[3]); w.z = cvt_pk_bf16(o1[0], o1[1]); w.w = cvt_pk_bf16(o1[2], o1[3]); *(u32x4*)(hb + off + bj * HALF) = w; }
                }
                if (!last) { ss += __shfl_xor(ss, 16); ss += __shfl_xor(ss, 32); ssm[m] = ss; }
            }
            if (!last) {
                const float sv = fq == 0 ? ssm[0] : fq == 1 ? ssm[1] : fq == 2 ? ssm[2] : ssm[3];
                ssq_out[(size_t)(u.pm * BM + ai * HALF + wr * 64 + fq * 16 + fr) * 16 + u.pn * 4 + wc] = sv; }
            asm volatile("" ::: "memory");
        }
    }
};

__device__ __forceinline__ void scan16_pair(float& a0, float& b0, float& a1, float& b1) {
    asm volatile(
        "s_nop 1\n\t"
        "v_fmac_f32_dpp %1, %1, %0 row_shr:1 row_mask:0xf bank_mask:0xf\n\t"
        "v_fmac_f32_dpp %3, %3, %2 row_shr:1 row_mask:0xf bank_mask:0xf\n\t"
        "v_mul_f32_dpp %0, %0, %0 row_shr:1 row_mask:0xf bank_mask:0xf\n\t"
        "v_mul_f32_dpp %2, %2, %2 row_shr:1 row_mask:0xf bank_mask:0xf\n\t"
        "v_fmac_f32_dpp %1, %1, %0 row_shr:2 row_mask:0xf bank_mask:0xf\n\t"
        "v_fmac_f32_dpp %3, %3, %2 row_shr:2 row_mask:0xf bank_mask:0xf\n\t"
        "v_mul_f32_dpp %0, %0, %0 row_shr:2 row_mask:0xf bank_mask:0xf\n\t"
        "v_mul_f32_dpp %2, %2, %2 row_shr:2 row_mask:0xf bank_mask:0xf\n\t"
        "v_fmac_f32_dpp %1, %1, %0 row_shr:4 row_mask:0xf bank_mask:0xf\n\t"
        "v_fmac_f32_dpp %3, %3, %2 row_shr:4 row_mask:0xf bank_mask:0xf\n\t"
        "v_mul_f32_dpp %0, %0, %0 row_shr:4 row_mask:0xf bank_mask:0xf\n\t"
        "v_mul_f32_dpp %2, %2, %2 row_shr:4 row_mask:0xf bank_mask:0xf\n\t"
        "v_fmac_f32_dpp %1, %1, %0 row_shr:8 row_mask:0xf bank_mask:0xf\n\t"
        "v_fmac_f32_dpp %3, %3, %2 row_shr:8 row_mask:0xf bank_mask:0xf\n\t"
        "v_mul_f32_dpp %0, %0, %0 row_shr:8 row_mask:0xf bank_mask:0xf\n\t"
        "v_mul_f32_dpp %2, %2, %2 row_shr:8 row_mask:0xf bank_mask:0xf\n\t"
        "s_nop 1"
        : "+v"(a0), "+v"(b0), "+v"(a1), "+v"(b1));
}
struct EpiGate {
    static constexpr bool PERM = true; static constexpr int RS_MODE = 0;
    const float* ssq; int mode; const bf16_t* rec; const bf16_t* gate; bf16_t* Y; const float* bg; const float* SP8; float* SA; float* SB;
    __device__ __forceinline__ void half(AccH& acc, const Unit& u, const int ai, int wr, int wc, int fr, int fq, LAS unsigned char* xl, int tid) const {
        asm volatile("" : "+v"(fr), "+v"(fq), "+v"(tid));
        LAS f32x2* seg = (LAS f32x2*)(xl + 2048);
        LAS f32x2* part = (LAS f32x2*)(xl + 2048 + 4096);
        const int ch0 = 32 * wc + 8 * fq, cg0 = 128 * u.pn + ch0;
        const unsigned boff = (unsigned)((u.pm * BM + ai * HALF + wr * 64 + 4 * fr) * D + cg0) * 2u;
        if (mode == 2) { asm volatile("s_waitcnt lgkmcnt(0)\n\ts_barrier" ::: "memory"); return; }
        u32x4 xrr[4];
#pragma unroll
        for (int m = 0; m < 4; ++m) xrr[m] = *(const u32x4*)((const char*)rec + (boff + (unsigned)(m * D * 2)));
        if (mode == 1 && ai == 0) {
            const int j = u.pm & 63, pb = u.pm - j, ch = tid & 127, p = tid >> 7;
            float ca = 1.f, cb = 0.f;
            float Av[16], Bv[16];
#pragma unroll
            for (int i = 0; i < 16; ++i) { const int jj = 16 * p + i; const bool ok = jj < j; const size_t o = (size_t)(pb + (ok ? jj : 0)) * D + 128 * u.pn + ch;
                const float av = SA[o], bv = SB[o]; Av[i] = ok ? av : 1.f; Bv[i] = ok ? bv : 0.f; }
#pragma unroll
            for (int i = 0; i < 16; ++i) { cb = Bv[i] + Av[i] * cb; ca *= Av[i]; }
            part[p * 128 + ch] = (f32x2){ca, cb};
            asm volatile("" ::: "memory"); __builtin_amdgcn_sched_barrier(0);
        }
#pragma unroll
        for (int n = 0; n < 2; ++n) {
            const f32x4 sp8 = *(const f32x4*)(SP8 + cg0 + 4 * n);
            const f32x4 bR = *(const f32x4*)(bg + 256 * u.pn + ch0 + 4 * n) * (-LOG2E), bI = *(const f32x4*)(bg + 256 * u.pn + 128 + ch0 + 4 * n) * (-LOG2E);
#pragma unroll
            for (int m = 0; m < 4; ++m) {
                const unsigned xa = n ? xrr[m].z : xrr[m].x, xb = n ? xrr[m].w : xrr[m].y;
                const float xv[4] = {bf_lo(xa), bf_hi(xa), bf_lo(xb), bf_hi(xb)};
                float av[4], bv[4];
#pragma unroll
                for (int jp = 0; jp < 2; ++jp) {
                    const f32x2 aR = (f32x2){acc[0][m][n][2 * jp], acc[0][m][n][2 * jp + 1]}, aI = (f32x2){acc[1][m][n][2 * jp], acc[1][m][n][2 * jp + 1]};
                    const f32x2 tR = aR * (-LOG2E) + (f32x2){bR[2 * jp], bR[2 * jp + 1]}, tI = aI * (-LOG2E) + (f32x2){bI[2 * jp], bI[2 * jp + 1]};
                    const f32x2 dR = (f32x2){fast_exp2(tR.x), fast_exp2(tR.y)} + 1.f, dI = (f32x2){fast_exp2(tI.x), fast_exp2(tI.y)} + 1.f;
                    const f32x2 dd = dR * dI;
                    const f32x2 inv = (f32x2){fast_rcp(dd.x), fast_rcp(dd.y)};
                    const f32x2 rg = inv * dI, ig = inv * dR;
                    const f32x2 la2 = rg * (f32x2){-sp8[2 * jp], -sp8[2 * jp + 1]};
                    const f32x2 a = (f32x2){fast_exp2(la2.x), fast_exp2(la2.y)}, x2 = la2 * (2.f / LOG2E);
                    const f32x2 pq = -x2 * (x2 * (x2 * (x2 * 0.041666668f + 0.16666667f) + 0.5f) + 1.f), qq = 1.f - a * a;
                    const f32x2 om = (f32x2){(x2.x > -0.02f) ? pq.x : qq.x, (x2.y > -0.02f) ? pq.y : qq.y};
                    const f32x2 bb = (f32x2){__builtin_amdgcn_sqrtf(om.x), __builtin_amdgcn_sqrtf(om.y)} * ig * (f32x2){xv[2 * jp], xv[2 * jp + 1]};
                    av[2 * jp] = a.x; av[2 * jp + 1] = a.y; bv[2 * jp] = bb.x; bv[2 * jp + 1] = bb.y;
                }
#pragma unroll
                for (int j = 0; j < 4; ++j) { acc[0][m][n][j] = av[j]; acc[1][m][n][j] = bv[j]; }
                asm volatile("" ::: "memory"); __builtin_amdgcn_sched_barrier(0);
            }
        }
#pragma unroll
        for (int n = 0; n < 2; ++n) {
            float ta[4], tb[4];
#pragma unroll
            for (int j = 0; j < 4; ++j) {
#pragma unroll
                for (int m = 1; m < 4; ++m) { acc[1][m][n][j] = acc[0][m][n][j] * acc[1][m - 1][n][j] + acc[1][m][n][j]; acc[0][m][n][j] = acc[0][m][n][j] * acc[0][m - 1][n][j]; }
                ta[j] = acc[0][3][n][j]; tb[j] = acc[1][3][n][j];
            }
            scan16_pair(ta[0], tb[0], ta[1], tb[1]); scan16_pair(ta[2], tb[2], ta[3], tb[3]);
#pragma unroll
            for (int j = 0; j < 4; ++j) {
                if (fr == 15) seg[(2 * ai + wr) * 128 + ch0 + 4 * n + j] = (f32x2){ta[j], tb[j]};
                const float ea = __int_as_float(__builtin_amdgcn_update_dpp(__float_as_int(1.f), __float_as_int(ta[j]), 0x111, 0xf, 0xf, false));
                const float eb = __int_as_float(__builtin_amdgcn_update_dpp(__float_as_int(0.f), __float_as_int(tb[j]), 0x111, 0xf, 0xf, false));
#pragma unroll
                for (int m = 0; m < 4; ++m) { acc[1][m][n][j] = acc[1][m][n][j] + acc[0][m][n][j] * eb; acc[0][m][n][j] = acc[0][m][n][j] * ea; }
            }
            asm volatile("" ::: "memory"); __builtin_amdgcn_sched_barrier(0);
        }
        u32x4 grr[4];
        if (mode == 1) {
#pragma unroll
            for (int m = 0; m < 4; ++m) grr[m] = *(const u32x4*)((const char*)gate + (boff + (unsigned)(m * D * 2)));
        }
        if (!(mode == 0 && ai == 0)) asm volatile("s_waitcnt lgkmcnt(0)\n\ts_barrier" ::: "memory");
        if (mode == 0) {
            if (ai == 1 && tid < 128) { float A = 1.f, B = 0.f;
#pragma unroll
                for (int s = 0; s < 4; ++s) { const f32x2 v = seg[s * 128 + tid]; B = v.y + v.x * B; A *= v.x; }
                SA[(size_t)u.pm * D + 128 * u.pn + tid] = A; SB[(size_t)u.pm * D + 128 * u.pn + tid] = B; }
        } else {
            const int sme = 2 * ai + wr;
#pragma unroll
            for (int n = 0; n < 2; ++n) {
#pragma unroll
                for (int j = 0; j < 4; ++j) {
                    const int ch = ch0 + 4 * n + j;
                    float c = 0.f;
#pragma unroll
                    for (int p = 0; p < 4; ++p) { const f32x2 v = part[p * 128 + ch]; c = v.y + v.x * c; }
#pragma unroll
                    for (int s = 0; s < 3; ++s) { if (s < 2 * ai + 1) { const f32x2 v = seg[s * 128 + ch]; const float cn = v.y + v.x * c; c = (s < sme) ? cn : c; } }
#pragma unroll
                    for (int m = 0; m < 4; ++m) acc[1][m][n][j] = acc[1][m][n][j] + acc[0][m][n][j] * c;
                    asm volatile("" ::: "memory"); __builtin_amdgcn_sched_barrier(0);
                }
            }
#pragma unroll
            for (int m = 0; m < 4; ++m) {
                unsigned bo = boff; asm volatile("" : "+v"(bo));
                const u32x4 gr = grr[m]; const f32x4 h0 = acc[1][m][0], h1 = acc[1][m][1];
                u32x4 w; w.x = cvt_pk_bf16(bf_lo(gr.x) * h0[0], bf_hi(gr.x) * h0[1]); w.y = cvt_pk_bf16(bf_lo(gr.y) * h0[2], bf_hi(gr.y) * h0[3]);
                w.z = cvt_pk_bf16(bf_lo(gr.z) * h1[0], bf_hi(gr.z) * h1[1]); w.w = cvt_pk_bf16(bf_lo(gr.w) * h1[2], bf_hi(gr.w) * h1[3]);
                *(u32x4*)((char*)Y + (bo + (unsigned)(m * D * 2))) = w;
                asm volatile("" ::: "memory"); __builtin_amdgcn_sched_barrier(0);
            }
        }
    }
};
}

__device__ __forceinline__ int crow(int r, int hi) { return (r & 3) + 8 * (r >> 2) + 4 * hi; }
__device__ __forceinline__ void attn_unit(int b, int h, int chunk, int half, const bf16_t* Q, const bf16_t* __restrict__ Kb, const bf16_t* __restrict__ VT, bf16_t* O,
                                          const float* __restrict__ rel_bias, LAS float* wscr, int lane) {
    const int r32 = lane & 31, hi = lane >> 5;
    const long row0 = (long)b * SEQ + 64 * chunk + 32 * half;
    bf16x8 qr[4];
    const char* qbp = (const char*)(Q + row0 * D + 64 * h);
    const unsigned qoff = (unsigned)(r32 * D + 8 * hi) * 2u, l16 = (unsigned)lane * 16u;
#pragma unroll
    for (int d0 = 0; d0 < 4; ++d0) qr[d0] = *(const bf16x8*)(qbp + (qoff + 32u * d0));
    f32x16 o0, o1;
#pragma unroll
    for (int r = 0; r < 16; ++r) { o0[r] = 0.f; o1[r] = 0.f; }
    float mhat = 0.f, l = 0.f;
    f32x16 negm;
#pragma unroll
    for (int r = 0; r < 16; ++r) negm[r] = 0.f;
    asm volatile("" : "+v"(negm));
    const int t0 = chunk < 8 ? 8 - chunk : 0;
    const char* kbp = (const char*)Kb + (size_t)(b * NH + h) * (SEQ / 32) * 4 * 1024 + (long)(chunk - 8) * 8 * 1024;
    const char* vbp = (const char*)VT + (size_t)(b * NH + h) * (SEQ / 64) * 8 * 1024 + (long)(chunk - 8) * 8 * 1024;
    LAS float* wb = wscr + 64;
    { const float* bias_h = rel_bias + h * NREL;
      const float cb = bias_h[NREL - 1];
#pragma unroll
      for (int i = 0; i < 4; ++i) { const int idx = lane + 64 * i; wb[idx] = (bias_h[idx < NREL - 1 ? idx : NREL - 1] - cb) * LOG2E; }
      asm volatile("s_waitcnt lgkmcnt(0)" ::: "memory"); }
    const int qi = 32 * half + r32;
    const int rot = (chunk >= 8) ? (17 - chunk % 9) % 9 : 0;
    bf16x8 kf[2][4];
    { const int tf = (t0 + rot) % 9;
#pragma unroll
      for (int kh = 0; kh < 2; ++kh)
#pragma unroll
          for (int d0 = 0; d0 < 4; ++d0) kf[kh][d0] = *(const bf16x8*)(kbp + (size_t)((tf * 2 + kh) * 4 + d0) * 1024 + l16); }
    for (int s = t0; s < 9; ++s) {
        const int t = (s + rot) % 9;
        bf16x8 vf[2][2][2];
#pragma unroll
        for (int dh = 0; dh < 2; ++dh)
#pragma unroll
            for (int kh = 0; kh < 2; ++kh)
#pragma unroll
                for (int sl = 0; sl < 2; ++sl) vf[dh][kh][sl] = *(const bf16x8*)(vbp + (size_t)(t * 8 + dh * 4 + kh * 2 + sl) * 1024 + l16);
        f32x16 p0, p1;
        p0 = __builtin_amdgcn_mfma_f32_32x32x16_bf16(kf[0][0], qr[0], negm, 0, 0, 0); p1 = __builtin_amdgcn_mfma_f32_32x32x16_bf16(kf[1][0], qr[0], negm, 0, 0, 0);
#pragma unroll
        for (int d0 = 1; d0 < 4; ++d0) { p0 = __builtin_amdgcn_mfma_f32_32x32x16_bf16(kf[0][d0], qr[d0], p0, 0, 0, 0); p1 = __builtin_amdgcn_mfma_f32_32x32x16_bf16(kf[1][d0], qr[d0], p1, 0, 0, 0); }
        { const int tn = s < 8 ? (s + 1 + rot) % 9 : t;
          __builtin_amdgcn_sched_barrier(0);
#pragma unroll
          for (int kh = 0; kh < 2; ++kh)
#pragma unroll
              for (int d0 = 0; d0 < 4; ++d0) kf[kh][d0] = *(const bf16x8*)(kbp + (size_t)((tn * 2 + kh) * 4 + d0) * 1024 + l16);
          __builtin_amdgcn_sched_barrier(0); }
        if (t > 5) {
            const LAS float* wq = wb + (qi + 64 * (8 - t) - 8 * hi + 63);
#pragma unroll
            for (int r = 0; r < 16; ++r) { const int kk = 16 * (r >> 3) + (r & 7); p0[r] += wq[-kk]; p1[r] += wq[-kk - 32]; }
        }
        float rm;
        { float ma = fmaxf(fmaxf(p0[0], p0[1]), p1[0]), mb = fmaxf(fmaxf(p0[2], p0[3]), p1[1]); ma = fmaxf(fmaxf(ma, p1[2]), p1[3]);
#pragma unroll
          for (int r = 4; r < 16; r += 4) { ma = fmaxf(fmaxf(ma, p0[r]), p0[r + 1]); mb = fmaxf(fmaxf(mb, p0[r + 2]), p0[r + 3]); ma = fmaxf(fmaxf(ma, p1[r]), p1[r + 1]); mb = fmaxf(fmaxf(mb, p1[r + 2]), p1[r + 3]); }
          rm = fmaxf(ma, mb); }
        rm = fmaxf(rm, __shfl_xor(rm, 32));
        if (s == t0 || __any(rm > 8.f)) {
            const float dl = (s == t0) ? rm : fmaxf(rm, 0.f), alpha = fast_exp2(-dl);
            mhat += dl; l *= alpha;
#pragma unroll
            for (int r = 0; r < 16; ++r) { p0[r] -= dl; p1[r] -= dl; negm[r] = -mhat; }
            asm volatile("" : "+v"(negm));
            if (hi == 0) wscr[r32] = alpha;
            asm volatile("s_waitcnt lgkmcnt(0)" ::: "memory");
#pragma unroll
            for (int r = 0; r < 16; ++r) { const float al = wscr[crow(r, hi)]; o0[r] *= al; o1[r] *= al; }
            asm volatile("s_waitcnt lgkmcnt(0)" ::: "memory");
        }
#pragma unroll
        for (int r = 0; r < 16; ++r) { p0[r] = fast_exp2(p0[r]); p1[r] = fast_exp2(p1[r]); }
        { const f32x16 sv = p0 + p1;
          typedef float f32x8 __attribute__((ext_vector_type(8)));
          const f32x8 s8 = sv.lo + sv.hi; const f32x4 s4 = s8.lo + s8.hi; const f32x2 s2 = s4.lo + s4.hi;
          l += s2.x + s2.y; }
        bf16x8 pa[2][2];
#pragma unroll
        for (int sl = 0; sl < 2; ++sl) {
            u32x4 w0, w1;
            w0.x = cvt_pk_bf16(p0[8 * sl + 0], p0[8 * sl + 1]); w0.y = cvt_pk_bf16(p0[8 * sl + 2], p0[8 * sl + 3]); w0.z = cvt_pk_bf16(p0[8 * sl + 4], p0[8 * sl + 5]); w0.w = cvt_pk_bf16(p0[8 * sl + 6], p0[8 * sl + 7]);
            w1.x = cvt_pk_bf16(p1[8 * sl + 0], p1[8 * sl + 1]); w1.y = cvt_pk_bf16(p1[8 * sl + 2], p1[8 * sl + 3]); w1.z = cvt_pk_bf16(p1[8 * sl + 4], p1[8 * sl + 5]); w1.w = cvt_pk_bf16(p1[8 * sl + 6], p1[8 * sl + 7]);
            pa[0][sl] = __builtin_bit_cast(bf16x8, w0); pa[1][sl] = __builtin_bit_cast(bf16x8, w1);
        }
#pragma unroll
        for (int kh = 0; kh < 2; ++kh)
#pragma unroll
            for (int sl = 0; sl < 2; ++sl) {
                o0 = __builtin_amdgcn_mfma_f32_32x32x16_bf16(pa[kh][sl], vf[0][kh][sl], o0, 0, 0, 0);
                o1 = __builtin_amdgcn_mfma_f32_32x32x16_bf16(pa[kh][sl], vf[1][kh][sl], o1, 0, 0, 0);
            }
    }
    l += __shfl_xor(l, 32);
    if (hi == 0) wscr[r32] = 1.0f / l;
    asm volatile("s_waitcnt lgkmcnt(0)" ::: "memory");
    char* obp = (char*)(O + row0 * D + 64 * h);
    const unsigned ooff = (unsigned)(4 * hi * D + r32) * 2u;
#pragma unroll
    for (int r = 0; r < 16; ++r) { const int q = crow(r, hi); const float il = wscr[q];
        const unsigned w0 = cvt_pk_bf16(o0[r] * il, 0.f), w1 = cvt_pk_bf16(o1[r] * il, 0.f);
        *(bf16_t*)(obp + (size_t)(((r & 3) + 8 * (r >> 2)) * D * 2) + ooff) = (bf16_t)w0; *(bf16_t*)(obp + (size_t)(((r & 3) + 8 * (r >> 2)) * D * 2 + 64) + ooff) = (bf16_t)w1; }
    asm volatile("s_waitcnt lgkmcnt(0)" ::: "memory");
}

__device__ __forceinline__ void attn_half(f32x16& p0, f32x16& p1, f32x16& o0, f32x16& o1, float& mhat, float& l, const bf16x8 (&vf)[2][2][2],
                                          const bool first, const int t, const int qi, const int hi, const int r32, LAS float* wscr, const LAS float* wb) {
    if (t > 5) {
        const LAS float* wq = wb + (qi + 64 * (8 - t) - 8 * hi + 63);
#pragma unroll
        for (int r = 0; r < 16; ++r) { const int kk = 16 * (r >> 3) + (r & 7); p0[r] += wq[-kk]; p1[r] += wq[-kk - 32]; }
    }
    float rm;
    { float ma = fmaxf(fmaxf(p0[0], p0[1]), p1[0]), mb = fmaxf(fmaxf(p0[2], p0[3]), p1[1]); ma = fmaxf(fmaxf(ma, p1[2]), p1[3]);
#pragma unroll
      for (int r = 4; r < 16; r += 4) { ma = fmaxf(fmaxf(ma, p0[r]), p0[r + 1]); mb = fmaxf(fmaxf(mb, p0[r + 2]), p0[r + 3]); ma = fmaxf(fmaxf(ma, p1[r]), p1[r + 1]); mb = fmaxf(fmaxf(mb, p1[r + 2]), p1[r + 3]); }
      rm = fmaxf(ma, mb); }
    rm = fmaxf(rm, __shfl_xor(rm, 32)) - mhat;
    if (__any(rm > 64.f || (first && rm < -64.f))) {
        const float dl = first ? rm : fmaxf(rm, 0.f), alpha = first ? 1.f : fast_exp2(-dl);
        mhat += dl; l *= alpha;
        if (hi == 0) wscr[r32] = alpha;
        asm volatile("s_waitcnt lgkmcnt(0)" ::: "memory");
#pragma unroll
        for (int r = 0; r < 16; ++r) { const float al = wscr[crow(r, hi)]; o0[r] *= al; o1[r] *= al; }
        asm volatile("s_waitcnt lgkmcnt(0)" ::: "memory");
    }
    if (__any(mhat != 0.f)) {
#pragma unroll
        for (int r = 0; r < 16; ++r) { p0[r] -= mhat; p1[r] -= mhat; }
    }
    float ls = 0.f;
#define ATTN_SLAB(P, KH, SL) do { \
        float e_[8]; _Pragma("unroll") for (int j = 0; j < 8; ++j) e_[j] = fast_exp2(P[8 * (SL) + j]); \
        ls += ((e_[0] + e_[1]) + (e_[2] + e_[3])) + ((e_[4] + e_[5]) + (e_[6] + e_[7])); \
        u32x4 w_; w_.x = cvt_pk_bf16(e_[0], e_[1]); w_.y = cvt_pk_bf16(e_[2], e_[3]); w_.z = cvt_pk_bf16(e_[4], e_[5]); w_.w = cvt_pk_bf16(e_[6], e_[7]); \
        const bf16x8 pa_ = __builtin_bit_cast(bf16x8, w_); \
        o0 = __builtin_amdgcn_mfma_f32_32x32x16_bf16(pa_, vf[0][KH][SL], o0, 0, 0, 0); \
        o1 = __builtin_amdgcn_mfma_f32_32x32x16_bf16(pa_, vf[1][KH][SL], o1, 0, 0, 0); \
        __builtin_amdgcn_sched_barrier(0); } while (0)
    ATTN_SLAB(p0, 0, 0); ATTN_SLAB(p0, 0, 1); ATTN_SLAB(p1, 1, 0); ATTN_SLAB(p1, 1, 1);
#undef ATTN_SLAB
    l += ls;
}
__device__ __forceinline__ void attn_store_half(const f32x16& o0, const f32x16& o1, float l, char* obp, const int hi, const int r32, LAS float* wscr) {
    l += __shfl_xor(l, 32);
    if (hi == 0) wscr[r32] = 1.0f / l;
    asm volatile("s_waitcnt lgkmcnt(0)" ::: "memory");
    const unsigned ooff = (unsigned)(4 * hi * D + r32) * 2u;
#pragma unroll
    for (int r = 0; r < 16; ++r) { const int q = crow(r, hi); const float il = wscr[q];
        const unsigned w0 = cvt_pk_bf16(o0[r] * il, 0.f), w1 = cvt_pk_bf16(o1[r] * il, 0.f);
        *(bf16_t*)(obp + (size_t)(((r & 3) + 8 * (r >> 2)) * D * 2) + ooff) = (bf16_t)w0; *(bf16_t*)(obp + (size_t)(((r & 3) + 8 * (r >> 2)) * D * 2 + 64) + ooff) = (bf16_t)w1; }
    asm volatile("s_waitcnt lgkmcnt(0)" ::: "memory");
}
__device__ __forceinline__ void attn_unit64(int b, int h, int chunk, const bf16_t* Q, const bf16_t* __restrict__ Kb, const bf16_t* __restrict__ VT, bf16_t* O,
                                            const float* __restrict__ rel_bias, LAS float* wscr, LAS bf16x8* qlds, int lane) {
    asm volatile("" : "+v"(lane));
    const int r32 = lane & 31, hi = lane >> 5;
    const long row0 = (long)b * SEQ + 64 * chunk;
    const char* qbp = (const char*)(Q + row0 * D + 64 * h);
    const unsigned qoff = (unsigned)(r32 * D + 8 * hi) * 2u, l16 = (unsigned)lane * 16u;
#pragma unroll
    for (int hf = 0; hf < 2; ++hf)
#pragma unroll
        for (int d0 = 0; d0 < 4; ++d0) qlds[(hf * 4 + d0) * 64 + lane] = *(const bf16x8*)(qbp + (size_t)(hf * 32 * D * 2) + (qoff + 32u * d0));
    f32x16 oA0, oA1, oB0, oB1;
#pragma unroll
    for (int r = 0; r < 16; ++r) { oA0[r] = 0.f; oA1[r] = 0.f; oB0[r] = 0.f; oB1[r] = 0.f; }
    float mhatA = 0.f, lA = 0.f, mhatB = 0.f, lB = 0.f;
    const int t0 = chunk < 8 ? 8 - chunk : 0;
    const char* kbp = (const char*)Kb + (size_t)(b * NH + h) * (SEQ / 32) * 4 * 1024 + (long)(chunk - 8) * 8 * 1024;
    const char* vbp = (const char*)VT + (size_t)(b * NH + h) * (SEQ / 64) * 8 * 1024 + (long)(chunk - 8) * 8 * 1024;
    LAS float* wb = wscr + 64;
    { const float* bias_h = rel_bias + h * NREL;
      const float cb = bias_h[NREL - 1];
#pragma unroll
      for (int i = 0; i < 4; ++i) { const int idx = lane + 64 * i; const unsigned bo = (unsigned)(idx < NREL - 1 ? idx : NREL - 1) * 4u; wb[idx] = (*(const float*)((const char*)bias_h + bo) - cb) * LOG2E; }
      asm volatile("s_waitcnt lgkmcnt(0)" ::: "memory"); }
    const int rot = (chunk >= 8) ? (17 - chunk % 9) % 9 : 0;
    bf16x8 kf[2][4];
    { const int tf = (t0 + rot) % 9;
#pragma unroll
      for (int kh = 0; kh < 2; ++kh)
#pragma unroll
          for (int d0 = 0; d0 < 4; ++d0) kf[kh][d0] = *(const bf16x8*)(kbp + (size_t)((tf * 2 + kh) * 4 + d0) * 1024 + l16); }
    for (int s = t0; s < 9; ++s) {
        const int t = (s + rot) % 9;
        bf16x8 vf[2][2][2];
#pragma unroll
        for (int dh = 0; dh < 2; ++dh)
#pragma unroll
            for (int kh = 0; kh < 2; ++kh)
#pragma unroll
                for (int sl = 0; sl < 2; ++sl) vf[dh][kh][sl] = *(const bf16x8*)(vbp + (size_t)(t * 8 + dh * 4 + kh * 2 + sl) * 1024 + l16);
        f32x16 pA0, pA1, pB0, pB1;
#pragma unroll
        for (int r = 0; r < 16; ++r) { pA0[r] = 0.f; pA1[r] = 0.f; pB0[r] = 0.f; pB1[r] = 0.f; }
        asm volatile("" ::: "memory");
#pragma unroll
        for (int d0 = 0; d0 < 4; ++d0) {
            const bf16x8 qa = qlds[d0 * 64 + lane], qb = qlds[(4 + d0) * 64 + lane];
            pA0 = __builtin_amdgcn_mfma_f32_32x32x16_bf16(kf[0][d0], qa, pA0, 0, 0, 0); pA1 = __builtin_amdgcn_mfma_f32_32x32x16_bf16(kf[1][d0], qa, pA1, 0, 0, 0);
            pB0 = __builtin_amdgcn_mfma_f32_32x32x16_bf16(kf[0][d0], qb, pB0, 0, 0, 0); pB1 = __builtin_amdgcn_mfma_f32_32x32x16_bf16(kf[1][d0], qb, pB1, 0, 0, 0);
        }
        { const int tn = s < 8 ? (s + 1 + rot) % 9 : t;
          __builtin_amdgcn_sched_barrier(0);
#pragma unroll
          for (int kh = 0; kh < 2; ++kh)
#pragma unroll
              for (int d0 = 0; d0 < 4; ++d0) kf[kh][d0] = *(const bf16x8*)(kbp + (size_t)((tn * 2 + kh) * 4 + d0) * 1024 + l16);
          __builtin_amdgcn_sched_barrier(0); }
        attn_half(pA0, pA1, oA0, oA1, mhatA, lA, vf, s == t0, t, r32, hi, r32, wscr, wb);
        __builtin_amdgcn_sched_barrier(0);
        attn_half(pB0, pB1, oB0, oB1, mhatB, lB, vf, s == t0, t, 32 + r32, hi, r32, wscr, wb);
        __builtin_amdgcn_sched_barrier(0);
    }
    char* obp = (char*)(O + row0 * D + 64 * h);
    attn_store_half(oA0, oA1, lA, obp, hi, r32, wscr);
    attn_store_half(oB0, oB1, lB, obp + (size_t)32 * D * 2, hi, r32, wscr);
}

constexpr int NWAVES = 8;
constexpr size_t MiB = 1u << 20;
constexpr size_t WS_SP8 = 512 * 1024;
constexpr size_t WS_SSQ = 1 * MiB, WS_SA = 3 * MiB, WS_SB = 3 * MiB + 512 * 1024;
constexpr size_t WS_WIN = 4 * MiB, WS_WOUT = 8 * MiB, WS_WK = 10 * MiB, WS_WV = 12 * MiB, WS_WQ = 14 * MiB, WS_WO = 16 * MiB, WS_WUP0 = 18 * MiB, WS_WUP1 = 26 * MiB, WS_WDN0 = 34 * MiB, WS_WDN1 = 42 * MiB, WS_WG = 50 * MiB;
constexpr size_t WS_XB = 64 * MiB, WS_BIG = 128 * MiB;
constexpr size_t WS_GATE = WS_BIG, WS_RECPRE = WS_BIG + 64 * MiB, WS_REC = WS_BIG + 128 * MiB, WS_Y = WS_RECPRE;
constexpr size_t WS_K = WS_BIG, WS_VT = WS_BIG + 64 * MiB, WS_Q = WS_BIG + 128 * MiB, WS_O = WS_BIG + 192 * MiB, WS_FF = WS_BIG;
constexpr size_t WS_END = WS_BIG + 256 * MiB;
constexpr int RING_BYTES = 131072, XL_OFF = RING_BYTES, WSCR_OFF = XL_OFF + 2048 + 4096 + 4096, MISC_OFF = WSCR_OFF + NWAVES * 1280, LDS_BYTES = 152576;
static_assert(MISC_OFF + 64 <= LDS_BYTES, "LDS map");
constexpr int N_PHASES = 13;

__device__ __forceinline__ float wave_sum(float v) {
#pragma unroll
    for (int o = 1; o < 64; o <<= 1) v += __shfl_xor(v, o);
    return v;
}
__device__ __forceinline__ unsigned f2bf(float f) { unsigned u = __float_as_uint(f); return (u + 0x7fffu + ((u >> 16) & 1u)) >> 16; }
__device__ __forceinline__ unsigned pk2(float lo, float hi) { return f2bf(lo) | (f2bf(hi) << 16); }

__device__ __forceinline__ void transpose_item(const float* W, int ldw, int col0, int K, int N, const float* gain, bf16_t* WT, int headperm, LAS float* scr, int item, int lane) {
    const int nblk = N / 32, kb = item / nblk, nb = item % nblk, k0 = 64 * kb, n0 = 32 * nb;
    float wv[32];
#pragma unroll
    for (int i = 0; i < 32; ++i) { const int kk = 2 * i + (lane >> 5); wv[i] = W[(size_t)(k0 + kk) * ldw + col0 + n0 + (lane & 31)]; }
#pragma unroll
    for (int i = 0; i < 32; ++i) { const int kk = 2 * i + (lane >> 5); const float gv = gain ? gain[k0 + kk] : 1.f; scr[kk * 33 + (lane & 31)] = wv[i] * gv; }
    asm volatile("s_waitcnt lgkmcnt(0)" ::: "memory");
    const int n0o = headperm ? (256 * (n0 >> 8) + 128 * ((n0 >> 5) & 1) + 32 * ((n0 >> 6) & 3)) : n0;
    const int c = lane & 7;
#pragma unroll
    for (int j = 0; j < 4; ++j) { const int n = (lane >> 3) + 8 * j; const LAS float* s = scr + (8 * c) * 33 + n;
        u32x4 o; o.x = pk2(s[0 * 33], s[1 * 33]); o.y = pk2(s[2 * 33], s[3 * 33]); o.z = pk2(s[4 * 33], s[5 * 33]); o.w = pk2(s[6 * 33], s[7 * 33]);
        *(u32x4*)(WT + (size_t)(n0o + n) * K + k0 + 8 * c) = o; }
    asm volatile("s_waitcnt lgkmcnt(0)" ::: "memory");
}

#define XB_TMO      128
#define XB_XCNT(j)  (256  + 64 * (j))
#define XB_XSUB(j)  (1280 + 64 * (j))
#define XB_XGEN(j)  (2304 + 64 * (j))
#define XB_TOP      3328
#define XB_TOPGEN   3392
#define XCD_BAR_WORDS 3456
#define XB_SPIN_CAP (1u << 22)
__device__ __forceinline__ unsigned xb_ld(unsigned* p)              { return __hip_atomic_load(p, __ATOMIC_RELAXED, __HIP_MEMORY_SCOPE_AGENT); }
__device__ __forceinline__ unsigned xb_add(unsigned* p, unsigned v) { return __hip_atomic_fetch_add(p, v, __ATOMIC_RELAXED, __HIP_MEMORY_SCOPE_AGENT); }
__device__ __forceinline__ unsigned xb_xcc_id() { return (unsigned)__builtin_amdgcn_s_getreg((3 << 11) | 20) & 0xFu; }
#define XB_SPIN(cond, bar) do { unsigned _sp = 0; while (cond) { \
    if ((++_sp & 255u) == 0u) { if (xb_ld(&(bar)[XB_TMO])) break; if (_sp > XB_SPIN_CAP) { atomicAdd(&(bar)[XB_TMO], 1u); break; } } } } while (0)
struct XcdBarrier { unsigned* bar; unsigned x; volatile LAS unsigned* st; };
__device__ __forceinline__ XcdBarrier xcd_barrier_post(unsigned* bar, volatile LAS unsigned* st, const int tid) {
    XcdBarrier b; b.bar = bar; b.x = xb_xcc_id(); b.st = st;
    if (tid == 0) (void)xb_add(&bar[XB_XCNT(b.x)], 1u);
    return b;
}
__device__ __forceinline__ void xcd_barrier_complete(unsigned* bar, unsigned x, unsigned& nloc, unsigned& nx) {
    const unsigned G = gridDim.x * gridDim.y * gridDim.z;
    unsigned sum, cnt, mine, sp = 0u;
    for (;;) {
        sum = 0u; cnt = 0u; mine = 0u;
#pragma unroll
        for (unsigned j = 0; j < 16; ++j) { const unsigned c = xb_ld(&bar[XB_XCNT(j)]); sum += c; cnt += (c > 0u) ? 1u : 0u; mine = (j == x) ? c : mine; }
        if (sum == G) break;
        __builtin_amdgcn_s_sleep(1);
        if ((++sp & 255u) == 0u) { if (xb_ld(&bar[XB_TMO])) break; if (sp > XB_SPIN_CAP) { atomicAdd(&bar[XB_TMO], 1u); break; } }
    }
    nloc = mine > 0u ? mine : 1u; nx = cnt > 0u ? cnt : 1u;
}
__device__ __forceinline__ void xcd_barrier(const XcdBarrier& b, const int tid) {
    asm volatile("s_waitcnt vmcnt(0)" ::: "memory");
    __syncthreads();
    if (tid == 0) {
        unsigned* bar = b.bar;
        __builtin_amdgcn_s_waitcnt(0);
        unsigned nloc = b.st[0], nx = b.st[1];
        if (nloc == 0u) { xcd_barrier_complete(bar, b.x, nloc, nx); b.st[0] = nloc; b.st[1] = nx; }
        const unsigned old = xb_add(&bar[XB_XSUB(b.x)], 1u);
        const unsigned gen = old / nloc;
        if (old + 1u == (gen + 1u) * nloc) {
            __builtin_amdgcn_fence(__ATOMIC_RELEASE, "agent");
            asm volatile("s_waitcnt vmcnt(0)" ::: "memory");
            const unsigned og = xb_add(&bar[XB_TOP], 1u);
            const unsigned tg = og / nx;
            if (og + 1u == (tg + 1u) * nx) xb_add(&bar[XB_TOPGEN], 1u);
            else XB_SPIN(xb_ld(&bar[XB_TOPGEN]) == tg, bar);
            __builtin_amdgcn_fence(__ATOMIC_ACQUIRE, "agent");
            xb_add(&bar[XB_XGEN(b.x)], 1u);
            asm volatile("s_waitcnt vmcnt(0)" ::: "memory");
        } else {
            XB_SPIN(xb_ld(&bar[XB_XGEN(b.x)]) == gen, bar);
            __builtin_amdgcn_fence(__ATOMIC_ACQUIRE, "agent");
            asm volatile("s_waitcnt vmcnt(0)" ::: "memory");
        }
    }
    __syncthreads();
}

struct Args { const float* in[20]; float* out; unsigned char* ws; int ph_lo, ph_hi, coop, pad; };
enum { I_X = 0, I_ANORM, I_WIN, I_CONVW, I_CONVB, I_WGATE, I_BGATE, I_LAM, I_WOUT, I_KVNORM, I_WKV, I_KNORM, I_BNORM, I_WQ, I_QNORM, I_RELB, I_WO, I_MLPNORM, I_WUP, I_WDOWN };

__global__ void __launch_bounds__(NWAVES * 64, 2) yoco_fwd(Args a) {
    extern __shared__ __attribute__((aligned(16))) unsigned char lds_raw[];
    LAS unsigned char* lds = (LAS unsigned char*)lds_raw;
    LAS unsigned char* xl = lds + XL_OFF;
    const int G = gridDim.x, bx = blockIdx.x;
    const int vcu = (G % 8 == 0) ? (bx % 8) * (G / 8) + bx / 8 : bx;
    unsigned char* ws0 = a.ws;
    typedef const Args __attribute__((address_space(4))) * ArgsP;
    ArgsP ap0 = (ArgsP)__builtin_amdgcn_kernarg_segment_ptr();
    cg::grid_group grid = cg::this_grid();
    const int wave0 = __builtin_amdgcn_readfirstlane(threadIdx.x >> 6);
    volatile LAS unsigned* misc = (volatile LAS unsigned*)(lds + MISC_OFF);
    unsigned* ctl = (unsigned*)ws0;
    if (threadIdx.x < 2) misc[threadIdx.x] = 0u;
    if (a.coop && bx == 0) { for (int i = threadIdx.x; i < XCD_BAR_WORDS; i += NWAVES * 64) ctl[i] = 0u; }
    __syncthreads();
    XcdBarrier bar; bar.bar = ctl; bar.x = 0; bar.st = misc;
    if (a.coop) { grid.sync();
        bar = xcd_barrier_post(ctl, misc, (int)threadIdx.x); }

    for (int pi = a.ph_lo; pi < a.ph_hi + PROBE_REP_N; ++pi) {
        const int ph = (pi <= PROBE_REP_PH) ? pi : (pi - PROBE_REP_N < PROBE_REP_PH ? PROBE_REP_PH : pi - PROBE_REP_N);
            ArgsP ap = ap0; asm volatile("" : "+s"(ap));
        unsigned char* ws = ap->ws;
        float* ssq = (float*)(ws + WS_SSQ); float* SA = (float*)(ws + WS_SA); float* SB = (float*)(ws + WS_SB);
        bf16_t* Win_t = (bf16_t*)(ws + WS_WIN); bf16_t* Wout_t = (bf16_t*)(ws + WS_WOUT); bf16_t* Wk_t = (bf16_t*)(ws + WS_WK); bf16_t* Wv_t = (bf16_t*)(ws + WS_WV);
        bf16_t* Wq_t = (bf16_t*)(ws + WS_WQ); bf16_t* Wo_t = (bf16_t*)(ws + WS_WO); bf16_t* Wg_t = (bf16_t*)(ws + WS_WG);
        bf16_t* XB = (bf16_t*)(ws + WS_XB); bf16_t* GATE = (bf16_t*)(ws + WS_GATE); bf16_t* RECPRE = (bf16_t*)(ws + WS_RECPRE); bf16_t* REC = (bf16_t*)(ws + WS_REC); bf16_t* Y = (bf16_t*)(ws + WS_Y);
        bf16_t* KB = (bf16_t*)(ws + WS_K); bf16_t* VT = (bf16_t*)(ws + WS_VT); bf16_t* QO = (bf16_t*)(ws + WS_Q); bf16_t* OB = (bf16_t*)(ws + WS_O); bf16_t* FFB = (bf16_t*)(ws + WS_FF);
        int tid; asm volatile("v_mbcnt_lo_u32_b32 %0, -1, 0\n\tv_mbcnt_hi_u32_b32 %0, -1, %0" : "=v"(tid)); tid += wave0 * 64; asm volatile("" : "+v"(tid));
        const int lane = tid & 63, wave = __builtin_amdgcn_readfirstlane(tid >> 6);
        if (pi > a.ph_lo && a.coop) xcd_barrier(bar, tid);
        if (pi == 2 && a.coop) { for (int xs = 0; xs < PROBE_XSYNC; ++xs) xcd_barrier(bar, tid); }
        if (ph == 0) {
            LAS float* scr = (LAS float*)(lds + wave * 16384);
            const int gw = vcu * NWAVES + wave, NGW = G * NWAVES;
            constexpr int I_in = 16 * 64, I_sq = 16 * 32, I_up = 16 * 128, I_dn = 64 * 32, I_g = 8 * 16;
            constexpr int NITEMS = I_in + 5 * I_sq + 2 * I_up + 2 * I_dn + I_g;
            for (int it = gw; it < NITEMS; it += NGW) {
                int r = it;
                if (r < I_in) { transpose_item(ap->in[I_WIN], 2 * D, 0, D, 2 * D, ap->in[I_ANORM], Win_t, 0, scr, r, lane); continue; } r -= I_in;
                if (r < I_sq) { transpose_item(ap->in[I_WOUT], D, 0, D, D, nullptr, Wout_t, 0, scr, r, lane); continue; } r -= I_sq;
                if (r < I_sq) { transpose_item(ap->in[I_WKV], 2 * D, 0, D, D, ap->in[I_KVNORM], Wk_t, 1, scr, r, lane); continue; } r -= I_sq;
                if (r < I_sq) { transpose_item(ap->in[I_WKV], 2 * D, D, D, D, ap->in[I_KVNORM], Wv_t, 0, scr, r, lane); continue; } r -= I_sq;
                if (r < I_sq) { transpose_item(ap->in[I_WQ], D, 0, D, D, ap->in[I_BNORM], Wq_t, 1, scr, r, lane); continue; } r -= I_sq;
                if (r < I_sq) { transpose_item(ap->in[I_WO], D, 0, D, D, nullptr, Wo_t, 0, scr, r, lane); continue; } r -= I_sq;
                if (r < 2 * I_up) { const int l = r / I_up; transpose_item(ap->in[I_WUP] + (size_t)l * D * FF, FF, 0, D, FF, ap->in[I_MLPNORM] + l * D, (bf16_t*)(ws + (l ? WS_WUP1 : WS_WUP0)), 0, scr, r % I_up, lane); continue; } r -= 2 * I_up;
                if (r < 2 * I_dn) { const int l = r / I_dn; transpose_item(ap->in[I_WDOWN] + (size_t)l * FF * D, D, 0, FF, D, nullptr, (bf16_t*)(ws + (l ? WS_WDN1 : WS_WDN0)), 0, scr, r % I_dn, lane); continue; } r -= 2 * I_dn;
                { const int blk = r / 16; transpose_item(ap->in[I_WGATE] + (size_t)blk * 128 * 256, 256, 0, 128, 256, nullptr, Wg_t + (size_t)blk * 256 * 128, 0, scr, r % 16, lane); }
            }
            { const float* lam = ap->in[I_LAM]; float* sp8 = (float*)(ws + WS_SP8);
              for (int c = bx * NWAVES * 64 + tid; c < D; c += G * NWAVES * 64) sp8[c] = 8.0f * LOG2E * log1pf(__expf(-lam[c])); }
            const float* x = ap->in[I_X];
            for (int m0 = 4 * gw; m0 < MTOK; m0 += 4 * NGW) {
                f32x4 v[4][4];
#pragma unroll
                for (int rr = 0; rr < 4; ++rr) { const f32x4* xr = (const f32x4*)(x + (size_t)(m0 + rr) * D) + lane;
#pragma unroll
                    for (int j = 0; j < 4; ++j) v[rr][j] = xr[64 * j]; }
#pragma unroll
                for (int rr = 0; rr < 4; ++rr) {
                    float s = 0.f;
#pragma unroll
                    for (int j = 0; j < 4; ++j) s += (v[rr][j][0] * v[rr][j][0] + v[rr][j][1] * v[rr][j][1]) + (v[rr][j][2] * v[rr][j][2] + v[rr][j][3] * v[rr][j][3]);
                    s = wave_sum(s);
                    u32x2* o8 = (u32x2*)(XB + (size_t)(m0 + rr) * D) + lane;
#pragma unroll
                    for (int j = 0; j < 4; ++j) { u32x2 w; w.x = cvt_pk_bf16(v[rr][j][0], v[rr][j][1]); w.y = cvt_pk_bf16(v[rr][j][2], v[rr][j][3]); o8[64 * j] = w; }
                    if (lane < 16) ssq[(size_t)(m0 + rr) * 16 + lane] = (lane == 0) ? s : 0.f;
                }
            }
            __syncthreads();
        }
        else if (ph == 1) {
            pg8::Gemm g{XB, Win_t, MTOK, 2 * D, D, D, D, 0}; pg8::StaticOrder S; S.init(MTOK, 2 * D, G, bx);
            pg8::EpiRowBf16<0> E{ssq, GATE, RECPRE, D};
            pg8::gemm_phase(lds, xl, g, S, E, tid);
        }
        else if (ph == 2) {
            const float* cw = ap->in[I_CONVW]; const float* cb = ap->in[I_CONVB];
            const long nth = (long)G * NWAVES * 64;
            for (long it = (long)bx * NWAVES * 64 + tid; it < (long)(MTOK / 8) * 128; it += nth) {
                const long row0 = (it >> 7) * 8; const int c = (int)(it & 127) * 8; const int s0 = (int)(row0 & (SEQ - 1));
                u32x4 xin[11];
#pragma unroll
                for (int i = 0; i < 11; ++i) { if (i >= 3 || s0 > 0) xin[i] = *(const u32x4*)(RECPRE + (size_t)(row0 - 3 + i) * D + c); else xin[i] = (u32x4){0u, 0u, 0u, 0u}; }
                f32x4 w0[4], w1[4];
#pragma unroll
                for (int k = 0; k < 4; ++k) { w0[k] = *(const f32x4*)(cw + k * D + c); w1[k] = *(const f32x4*)(cw + k * D + c + 4); }
                const f32x4 b0 = *(const f32x4*)(cb + c), b1 = *(const f32x4*)(cb + c + 4);
#pragma unroll
                for (int o = 0; o < 8; ++o) {
                    f32x4 a0 = b0, a1 = b1;
#pragma unroll
                    for (int k = 0; k < 4; ++k) { const u32x4 r = xin[o + k];
                        a0 += w0[k] * (f32x4){bf_lo(r.x), bf_hi(r.x), bf_lo(r.y), bf_hi(r.y)}; a1 += w1[k] * (f32x4){bf_lo(r.z), bf_hi(r.z), bf_lo(r.w), bf_hi(r.w)}; }
                    u32x4 ov; ov.x = cvt_pk_bf16(a0[0], a0[1]); ov.y = cvt_pk_bf16(a0[2], a0[3]); ov.z = cvt_pk_bf16(a1[0], a1[1]); ov.w = cvt_pk_bf16(a1[2], a1[3]);
                    *(u32x4*)(REC + (size_t)(row0 + o) * D + c) = ov;
                }
            }
        }
        else if (ph == 3 || ph == 4) {
            pg8::Gemm g{REC, Wg_t, MTOK, 8 * 256, 128, D, 128, 128 * 2}; pg8::StaticOrder S; S.init(MTOK, 8 * 256, G, bx);
            pg8::EpiGate E{ssq, (PROBE_REP_N > 0 && PROBE_VARIANT >= 2 && pi == PROBE_REP_PH) ? PROBE_VARIANT : ph - 3, REC, GATE, Y, ap->in[I_BGATE], (const float*)(ws + WS_SP8), SA, SB};
            if (wave >= 4) __builtin_amdgcn_s_setprio(1);
            pg8::gemm_k128_phase(lds, xl, g, S, E, tid);
            __builtin_amdgcn_s_setprio(0);
        }
        else if (ph == 5 || ph == 7 || ph == 10 || ph == 12) {
            const bf16_t* A = (ph == 5) ? Y : (ph == 10) ? OB : FFB;
            const bf16_t* Bt = (ph == 5) ? Wout_t : (ph == 10) ? Wo_t : (bf16_t*)(ws + (ph == 7 ? WS_WDN0 : WS_WDN1));
            const int K = (ph == 5 || ph == 10) ? D : FF;
            pg8::Gemm g{A, Bt, MTOK, D, K, K, K, 0}; pg8::StaticOrder S; S.init(MTOK, D, G, bx);
            pg8::EpiResid E{ssq, ap->out, XB, ssq, (ph == 12 || (PROBE_REP_N > 0 && pi == PROBE_REP_PH)) ? 1 : 0};
            pg8::gemm_phase(lds, xl, g, S, E, tid);
        }
        else if (ph == 6 || ph == 11) {
            pg8::Gemm g{XB, (bf16_t*)(ws + (ph == 6 ? WS_WUP0 : WS_WUP1)), MTOK, FF, D, D, D, 0}; pg8::StaticOrder S; S.init(MTOK, FF, G, bx, 4);
            pg8::EpiRowBf16<1> E{ssq, FFB, FFB, FF};
            pg8::gemm_phase(lds, xl, g, S, E, tid);
        }
        else if (ph == 8) {
            { pg8::Gemm g{Wv_t, XB, D, MTOK, D, D, D, 0}; pg8::StaticOrder S; S.init(D, MTOK, G, bx);
              pg8::EpiVT E{ssq, VT};
              pg8::gemm_phase(lds, xl, g, S, E, tid); }
            for (int w = 0; w < 2; ++w) {
                pg8::Gemm g{XB, w ? Wq_t : Wk_t, MTOK, D, D, D, D, 0}; pg8::StaticOrder S; S.init(MTOK, D, G, bx);
                if (w) { pg8::EpiHead<false> E{ssq, QO, ap->in[I_QNORM], QSCALE}; pg8::gemm_phase(lds, xl, g, S, E, tid); }
                else { pg8::EpiHead<true> E{ssq, KB, ap->in[I_KNORM], 1.f}; pg8::gemm_phase(lds, xl, g, S, E, tid); }
            }
        }
        else if (ph == 9) {
            LAS float* wscr = (LAS float*)(lds + WSCR_OFF) + wave * 320;
            if (wave >= 4) __builtin_amdgcn_s_setprio(1);
            LAS bf16x8* qlds = (LAS bf16x8*)(lds + wave * 8192);
            const int nit = (BATCH * NH * 256 + G * NWAVES - 1) / (G * NWAVES);
            for (int r = 0; r < nit; ++r) {
                int bh, ch;
                if (G == 256) { bh = (bx & 7) * 4 + r; ch = (bx >> 3) * 8 + wave; }
                else { const int it = r * G * NWAVES + bx * NWAVES + wave; if (it >= BATCH * NH * 256) break; bh = it >> 8; ch = it & 255; }
                attn_unit64(bh >> 4, bh & 15, ch, QO, KB, VT, OB, ap->in[I_RELB], wscr, qlds, lane);
            }
            __builtin_amdgcn_s_setprio(0);
        }
    }
}

extern "C" void kernel_launch(void* const* d_in, const int* in_sizes, int n_in, void* d_out, int out_size, void* d_ws, size_t ws_size, hipStream_t stream) {
    static int grid = 0;
    if (grid == 0) {
        if (n_in != 20 || in_sizes[0] != MTOK * D || out_size != MTOK * D || ws_size < WS_END) { fprintf(stderr, "kernel_launch: unexpected shapes (n_in %d in0 %d out %d ws %zu)\n", n_in, n_in > 0 ? in_sizes[0] : -1, out_size, ws_size); grid = -1; return; }
        int dev = 0, cus = 0, per_cu = 0;
        hipGetDevice(&dev); hipDeviceGetAttribute(&cus, hipDeviceAttributeMultiprocessorCount, dev);
        if (hipFuncSetAttribute((const void*)yoco_fwd, hipFuncAttributeMaxDynamicSharedMemorySize, LDS_BYTES) != hipSuccess) { fprintf(stderr, "kernel_launch: hipFuncSetAttribute failed\n"); grid = -1; return; }
        if (hipOccupancyMaxActiveBlocksPerMultiprocessor(&per_cu, (const void*)yoco_fwd, NWAVES * 64, LDS_BYTES) != hipSuccess || per_cu < 1) { fprintf(stderr, "kernel_launch: occupancy query says %d\n", per_cu); per_cu = 1; }
        (void)hipGetLastError();
        grid = cus;
        if (grid > cus * per_cu) grid = cus * per_cu;
    }
    if (grid < 0) return;
    Args a{};
    for (int i = 0; i < 20; ++i) a.in[i] = (const float*)d_in[i];
    a.out = (float*)d_out; a.ws = (unsigned char*)d_ws;
#if MK_MULTI
    for (int ph = 0; ph < N_PHASES; ++ph) { a.ph_lo = ph; a.ph_hi = ph + 1; a.coop = 0;
        hipLaunchKernelGGL(yoco_fwd, dim3(grid), dim3(NWAVES * 64), LDS_BYTES, stream, a); }
#else
    a.ph_lo = 0; a.ph_hi = N_PHASES; a.coop = 1;
    void* args[] = {&a};
    hipError_t e = hipLaunchCooperativeKernel((const void*)yoco_fwd, dim3(grid), dim3(NWAVES * 64), args, LDS_BYTES, stream);
    if (e != hipSuccess) fprintf(stderr, "kernel_launch: cooperative launch failed: %s (grid %d)\n", hipGetErrorString(e), grid);
#endif
}
```
